# Optimizing an MI355X kernel written in HIP

```python
import jax, jax.numpy as jnp
from jax import lax
import numpy as np

D_MODEL = 1024
BATCH = 8
SEQ = 2048
DEPTH = 1
DEC_BATCH = 128
DEC_SEQ = 4
PAST_LEN = 16384
PAGE_SIZE = 128

D_MIX = D_MODEL
D_CONV = D_MIX // 2
CONV_HEADS = 8
D_POOL = D_MIX - D_CONV
POOL_WINDOWS = (2, 4, 8, 16)
N_POOL_GROUPS = len(POOL_WINDOWS)
POOL_GC = D_POOL // N_POOL_GROUPS
POOL_MAX = max(POOL_WINDOWS)
CONV_W = 3
D_IN = 4 * D_CONV + 2 * D_POOL
EPS = 1e-6

kernel_name = "hymba_conv_pool_decoder_step"


def _rmsnorm(x, g):
    xf = x.astype(jnp.float32)
    r = lax.rsqrt(jnp.mean(xf * xf, axis=-1, keepdims=True) + EPS)
    return (xf * r).astype(x.dtype) * g


def _mixer(h, conv_buf, pool_buf, n_past, w_in, conv_w, pool_w, pool_scale, w_out):
    bsz, s, _ = h.shape
    proj = jnp.einsum('bsd,de->bse', h, w_in)
    b_g, c_g, u, z_a, v, z_b = jnp.split(
        proj, [D_CONV, 2 * D_CONV, 3 * D_CONV, 4 * D_CONV, 4 * D_CONV + D_POOL], axis=-1)

    cu = c_g * u
    up = jnp.concatenate([conv_buf.astype(cu.dtype), cu], axis=1)
    yc = conv_w[0] * up[:, 0:s]
    for k in range(1, CONV_W):
        yc = yc + conv_w[k] * up[:, k:k + s]
    y_a = b_g * yc * jax.nn.silu(z_a)
    new_conv = up[:, -(CONV_W - 1):]

    vp = jnp.concatenate([pool_buf.astype(v.dtype), v], axis=1)
    vpf = vp.astype(jnp.float32)
    cs = jnp.concatenate([jnp.zeros((bsz, 1, D_POOL), jnp.float32),
                          jnp.cumsum(vpf, axis=1)], axis=1)
    cs_end = cs[:, POOL_MAX:POOL_MAX + s]
    pos = n_past + jnp.arange(s, dtype=jnp.int32) + 1
    means = []
    for gi, w in enumerate(POOL_WINDOWS):
        sl = slice(gi * POOL_GC, (gi + 1) * POOL_GC)
        wsum = cs_end[..., sl] - cs[:, POOL_MAX - w:POOL_MAX - w + s, sl]
        cnt = jnp.minimum(pos, w).astype(jnp.float32)[None, :, None]
        means.append(wsum / cnt)
    mean = jnp.concatenate(means, axis=-1)
    pooled = (mean - v.astype(jnp.float32)).astype(v.dtype)
    pooled = pooled.reshape(bsz, s, N_POOL_GROUPS, POOL_GC)
    pooled = jnp.einsum('bsgc,gcd->bsgd', pooled, pool_w).reshape(bsz, s, D_POOL)
    y_b = pooled * pool_scale * jax.nn.silu(z_b)
    new_pool = vp[:, -(POOL_MAX - 1):]

    y = jnp.einsum('bse,ed->bsd', jnp.concatenate([y_a, y_b], axis=-1), w_out)
    return y, new_conv, new_pool


def setup_inputs(seed: int = 0) -> dict:
    key = jax.random.key(seed)
    ks = jax.random.split(key, 12)
    f32 = jnp.float32
    x_prompt = jax.random.normal(ks[0], (BATCH, SEQ, D_MODEL), f32)
    x_sample = jax.random.normal(ks[1], (DEC_BATCH, DEC_SEQ, D_MODEL), f32)
    state_conv = jax.random.normal(ks[2], (DEPTH, DEC_BATCH, CONV_W - 1, D_CONV), f32)
    state_pool = jax.random.normal(ks[3], (DEPTH, DEC_BATCH, POOL_MAX - 1, D_POOL), f32)
    norm_g = 1.0 + 0.02 * jax.random.normal(ks[4], (DEPTH, D_MODEL), f32)
    w_in = jax.random.normal(ks[5], (DEPTH, D_MODEL, D_IN), f32) * D_MODEL ** -0.5
    conv_w = jax.random.normal(ks[6], (DEPTH, CONV_W, D_CONV), f32) * CONV_W ** -0.5
    pool_w = jax.random.normal(ks[7], (DEPTH, N_POOL_GROUPS, POOL_GC, POOL_GC), f32) * POOL_GC ** -0.5
    pool_scale = 1.0 + 0.02 * jax.random.normal(ks[8], (DEPTH, D_POOL), f32)
    w_out = jax.random.normal(ks[9], (DEPTH, D_MIX, D_MODEL), f32) * D_MIX ** -0.5
    final_g = 1.0 + 0.02 * jax.random.normal(ks[10], (D_MODEL,), f32)
    return {"x_prompt": x_prompt, "x_sample": x_sample,
            "state_conv": state_conv, "state_pool": state_pool,
            "norm_g": norm_g, "w_in": w_in, "conv_w": conv_w, "pool_w": pool_w,
            "pool_scale": pool_scale, "w_out": w_out, "final_g": final_g}


def reference(x_prompt, x_sample, state_conv, state_pool, norm_g, w_in, conv_w, pool_w,
              pool_scale, w_out, final_g):
    hp, hs = x_prompt, x_sample
    zero_conv = jnp.zeros((BATCH, CONV_W - 1, D_CONV), x_prompt.dtype)
    zero_pool = jnp.zeros((BATCH, POOL_MAX - 1, D_POOL), x_prompt.dtype)
    conv_p, pool_p, conv_s, pool_s = [], [], [], []
    for l in range(DEPTH):
        yp, ncp, npp = _mixer(_rmsnorm(hp, norm_g[l]), zero_conv, zero_pool, 0,
                              w_in[l], conv_w[l], pool_w[l], pool_scale[l], w_out[l])
        ys, ncs, nps = _mixer(_rmsnorm(hs, norm_g[l]), state_conv[l], state_pool[l], PAST_LEN,
                              w_in[l], conv_w[l], pool_w[l], pool_scale[l], w_out[l])
        hp = hp + yp
        hs = hs + ys
        conv_p.append(ncp); pool_p.append(npp); conv_s.append(ncs); pool_s.append(nps)
    y_prompt = _rmsnorm(hp, final_g)
    y_sample = _rmsnorm(hs, final_g)
    new_state_conv_p = jnp.stack(conv_p, axis=0)
    new_state_pool_p = jnp.stack(pool_p, axis=0)
    new_state_conv_s = jnp.stack(conv_s, axis=0)
    new_state_pool_s = jnp.stack(pool_s, axis=0)
    return (y_prompt, y_sample, new_state_conv_p, new_state_pool_p, new_state_conv_s, new_state_pool_s)
```

```cpp
#include <hip/hip_runtime.h>
#include <hip/hip_cooperative_groups.h>
#include <cstdio>
namespace cg = cooperative_groups;

#define LAS __attribute__((address_space(3)))
typedef unsigned short bf16_t;
typedef short bf16x8 __attribute__((ext_vector_type(8)));
typedef float f32x4 __attribute__((ext_vector_type(4)));
typedef unsigned u32x4 __attribute__((ext_vector_type(4)));
typedef unsigned u32x2 __attribute__((ext_vector_type(2)));

constexpr int MP = 16384, MS = 512, MT = MP + MS, DM = 1024, DIN = 3072, DC = 512, DPL = 512;
constexpr int SEQ = 2048, DSEQ = 4;
constexpr float EPS = 1e-6f;
constexpr int BM = 256, BK = 64, HALF = 128, HTB = HALF * BK * 2, STAGE_BYTES = 8 * HTB, NXCD = 8, WGM = 8;
constexpr int LDS_BYTES = STAGE_BYTES;

constexpr size_t WS_XN = 0;
constexpr size_t WS_WIN = WS_XN + (size_t)MT * DM * 2;
constexpr size_t WS_WOUT = WS_WIN + (size_t)DIN * DM * 2;
constexpr size_t WS_PW = WS_WOUT + (size_t)DM * DM * 2;
constexpr size_t WS_PROJ = WS_PW + (size_t)4 * 128 * 128 * 2;
constexpr size_t WS_YB = WS_PROJ + (size_t)MT * DIN * 2;
constexpr size_t WS_POOLED = WS_YB + (size_t)MT * DM * 2;
constexpr size_t WS_END = WS_POOLED + (size_t)MT * DPL * 2;

constexpr size_t O_Y = 0;
constexpr size_t O_CONVP = (size_t)MT * DM;
constexpr size_t O_POOLP = O_CONVP + 8 * 2 * 512;
constexpr size_t O_CONVS = O_POOLP + 8 * 15 * 512;
constexpr size_t O_POOLS = O_CONVS + 128 * 2 * 512;

struct Params {
    const float *xp, *xs, *sconv, *spool, *norm_g, *w_in, *conv_w, *pool_w, *pool_scale, *w_out, *final_g;
    float* out;
    unsigned char* ws;
};

__device__ __forceinline__ unsigned cvt_pk_bf16(float lo, float hi) { unsigned r; asm volatile("v_cvt_pk_bf16_f32 %0, %1, %2" : "=v"(r) : "v"(lo), "v"(hi)); return r; }
__device__ __forceinline__ float bf_lo(unsigned w) { return __uint_as_float(w << 16); }
__device__ __forceinline__ float bf_hi(unsigned w) { return __uint_as_float(w & 0xffff0000u); }
__device__ __forceinline__ float wave_sum(float v) {
#pragma unroll
    for (int o = 1; o < 64; o <<= 1) v += __shfl_xor(v, o);
    return v;
}
__device__ __forceinline__ float silu(float z) { return z / (1.0f + __expf(-z)); }

struct F8 { float v[8]; };
__device__ __forceinline__ F8 ld_bf8(const bf16_t* p) {
    const u32x4 w = *(const u32x4*)p; F8 r;
    r.v[0] = bf_lo(w.x); r.v[1] = bf_hi(w.x); r.v[2] = bf_lo(w.y); r.v[3] = bf_hi(w.y);
    r.v[4] = bf_lo(w.z); r.v[5] = bf_hi(w.z); r.v[6] = bf_lo(w.w); r.v[7] = bf_hi(w.w); return r;
}
__device__ __forceinline__ F8 ld_f8(const float* p) {
    const f32x4 a = *(const f32x4*)p, b = *(const f32x4*)(p + 4); F8 r;
    r.v[0] = a.x; r.v[1] = a.y; r.v[2] = a.z; r.v[3] = a.w; r.v[4] = b.x; r.v[5] = b.y; r.v[6] = b.z; r.v[7] = b.w; return r;
}
__device__ __forceinline__ void st_f8(float* p, const F8& r) {
    *(f32x4*)p = (f32x4){r.v[0], r.v[1], r.v[2], r.v[3]}; *(f32x4*)(p + 4) = (f32x4){r.v[4], r.v[5], r.v[6], r.v[7]};
}
__device__ __forceinline__ void st_bf8(bf16_t* p, const F8& r) {
    u32x4 w; w.x = cvt_pk_bf16(r.v[0], r.v[1]); w.y = cvt_pk_bf16(r.v[2], r.v[3]); w.z = cvt_pk_bf16(r.v[4], r.v[5]); w.w = cvt_pk_bf16(r.v[6], r.v[7]);
    *(u32x4*)p = w;
}

__host__ __device__ __forceinline__ int lds_byte(int r, int c) { const int st = (r >> 4) * 2 + (c >> 5), rr = r & 15, cc = c & 31, ob = rr * 64 + cc * 2; return st * 1024 + (ob ^ (((ob >> 9) & 1) << 5)); }
__host__ __device__ __forceinline__ void stage_rc(int b, int& R, int& C) { const int st = b / 1024, sb = b % 1024, swz = sb ^ (((sb >> 9) & 1) << 5); R = (st >> 1) * 16 + swz / 64; C = (st & 1) * 32 + (swz % 64) / 2; }
__host__ __device__ __forceinline__ int perm32(int rho) { const int n = rho >> 4, i = rho & 15; return 8 * (i >> 2) + 4 * n + (i & 3); }

struct Unit { int pm, pn; };
struct Gemm { const bf16_t* A; const bf16_t* Bt; int M, N, K; };

struct StaticOrder {
    int nM, nN, nwg, G, c;
    __device__ void init(int M, int N, int G_, int c_) { nM = M / BM; nN = N / BM; nwg = nM * nN; G = G_; c = c_; }
    __device__ bool next(int i, Unit& u) const {
        const long L = (long)i * G + c; if (L >= nwg) return false;
        int wgid = (int)L; { const int q = nwg / NXCD, r = nwg % NXCD, xcd = wgid % NXCD, off = wgid / NXCD; wgid = (xcd < r ? xcd * (q + 1) : r * (q + 1) + (xcd - r) * q) + off; }
        const int nig = WGM * nN, gid = wgid / nig, fm = gid * WGM, gsz = (nM - fm) < WGM ? (nM - fm) : WGM;
        u.pm = fm + ((wgid % nig) % gsz); u.pn = (wgid % nig) / gsz; return true;
    }
};

struct EpiProj {
    static constexpr bool PERM = true;
    bf16_t* O;
    __device__ __forceinline__ void operator()(const f32x4 (&acc)[2][2][4][2], const Unit& u, int wr, int wc, int fr, int fq) const {
        const int row0 = u.pm * BM + wr * 64 + fr, col0 = u.pn * BM + wc * 32 + 8 * fq;
#pragma unroll
        for (int ai = 0; ai < 2; ++ai)
#pragma unroll
            for (int m = 0; m < 4; ++m) { bf16_t* rowp = O + (size_t)(row0 + ai * HALF + m * 16) * DIN + col0;
#pragma unroll
                for (int bj = 0; bj < 2; ++bj) { const f32x4 v0 = acc[ai][bj][m][0], v1 = acc[ai][bj][m][1];
                    u32x4 w; w.x = cvt_pk_bf16(v0[0], v0[1]); w.y = cvt_pk_bf16(v0[2], v0[3]); w.z = cvt_pk_bf16(v1[0], v1[1]); w.w = cvt_pk_bf16(v1[2], v1[3]);
                    *(u32x4*)(rowp + bj * HALF) = w; } }
    }
};
struct EpiOut {
    static constexpr bool PERM = false;
    float* out; const float* xp; const float* xs;
    __device__ __forceinline__ void operator()(const f32x4 (&acc)[2][2][4][2], const Unit& u, int wr, int wc, int fr, int fq) const {
        const int row0 = u.pm * BM + wr * 64 + fr, col0 = u.pn * BM + wc * 32 + 4 * fq;
        const float* xbase = (u.pm * BM < MP) ? xp : (xs - (size_t)MP * DM);
#pragma unroll
        for (int ai = 0; ai < 2; ++ai)
#pragma unroll
            for (int m = 0; m < 4; ++m) { const size_t ro = (size_t)(row0 + ai * HALF + m * 16) * DM + col0; float* rowp = out + ro; const float* xr = xbase + ro;
#pragma unroll
                for (int bj = 0; bj < 2; ++bj)
#pragma unroll
                    for (int n = 0; n < 2; ++n) *(f32x4*)(rowp + bj * HALF + n * 16) = acc[ai][bj][m][n] + *(const f32x4*)(xr + bj * HALF + n * 16); }
    }
};

template <class Epi, class Sched>
__device__ __forceinline__ void gemm_phase(LAS unsigned char* lds, const Gemm g, const Sched& S, const Epi& E) {
    const int tid = threadIdx.x, wid = __builtin_amdgcn_readfirstlane(tid >> 6), lane = tid & 63, wr = wid >> 2, wc = wid & 3, fr = lane & 15, fq = lane >> 4;
    const int K = g.K, nt = K / BK;
    unsigned voffA[2], voffB[2];
#pragma unroll
    for (int i = 0; i < 2; ++i) { int R, C; stage_rc(tid * 16 + i * 8192, R, C); const int Rb = Epi::PERM ? ((R & ~31) + perm32(R & 31)) : R;
        voffA[i] = (unsigned)(R * K + C) * 2u; voffB[i] = (unsigned)(Rb * K + C) * 2u; }
    const size_t kstep = (size_t)(BK * 2);
    const size_t hstep = (size_t)HALF * K * 2;
    const size_t tstep = 2 * hstep;
    const unsigned ldsw = (unsigned)wid * 1024u;
    const int aoff = lds_byte(wr * 64 + fr, fq * 8), boff = lds_byte(wc * 32 + fr, fq * 8);
#define PG8_SA(b, h) (((b) * 2 + (h)) * HTB)
#define PG8_SB(b, h) ((4 + (b) * 2 + (h)) * HTB)
#define PG8_STAGE(bufoff, gbase, voff) do { _Pragma("unroll") for (int _i = 0; _i < 2; ++_i) \
        __builtin_amdgcn_global_load_lds((const unsigned*)((const char*)(gbase) + (voff)[_i]), (LAS unsigned*)(lds + (bufoff) + ldsw + _i * 8192), 16, 0, 0); } while (0)
#define PG8_LDA(dst, b, h) do { _Pragma("unroll") for (int m = 0; m < 4; ++m) _Pragma("unroll") for (int k = 0; k < 2; ++k) dst[m][k] = *(const LAS bf16x8*)(lds + PG8_SA(b, h) + aoff + m * 2048 + k * 1024); } while (0)
#define PG8_LDB(dst, b, h) do { _Pragma("unroll") for (int n = 0; n < 2; ++n) _Pragma("unroll") for (int k = 0; k < 2; ++k) dst[n][k] = *(const LAS bf16x8*)(lds + PG8_SB(b, h) + boff + n * 2048 + k * 1024); } while (0)
#define PG8_MMA(ai, bj, At, Bt) do { __builtin_amdgcn_s_setprio(1); _Pragma("unroll") for (int m = 0; m < 4; ++m) _Pragma("unroll") for (int n = 0; n < 2; ++n) _Pragma("unroll") for (int k = 0; k < 2; ++k) \
        acc[ai][bj][m][n] = __builtin_amdgcn_mfma_f32_16x16x32_bf16(Bt[n][k], At[m][k], acc[ai][bj][m][n], 0, 0, 0); __builtin_amdgcn_s_setprio(0); } while (0)
#define PG8_WAIT_V(n) asm volatile("s_waitcnt vmcnt(" #n ")" ::: "memory")
#define PG8_WAIT_L(n) asm volatile("s_waitcnt lgkmcnt(" #n ")" ::: "memory")
#define PG8_BAR __builtin_amdgcn_s_barrier()
#define PG8_SCHED __builtin_amdgcn_sched_barrier(0)
    Unit cur, nxt; int ui = 0;
    if (!S.next(0, cur)) return;
    f32x4 acc[2][2][4][2];
#pragma unroll
    for (int a = 0; a < 2; ++a)
#pragma unroll
        for (int b = 0; b < 2; ++b)
#pragma unroll
            for (int m = 0; m < 4; ++m)
#pragma unroll
                for (int n = 0; n < 2; ++n) acc[a][b][m][n] = (f32x4){0.f, 0.f, 0.f, 0.f};
    bf16x8 At[4][2], B0[2][2], B1[2][2];
    const char* cA = (const char*)g.A + (size_t)cur.pm * tstep; const char* cB = (const char*)g.Bt + (size_t)cur.pn * tstep;
    PG8_STAGE(PG8_SB(0, 0), cB, voffB); PG8_STAGE(PG8_SA(0, 0), cA, voffA); PG8_STAGE(PG8_SB(0, 1), cB + hstep, voffB); PG8_STAGE(PG8_SA(0, 1), cA + hstep, voffA);
    if (wr == 1) PG8_BAR;
    PG8_WAIT_V(4); PG8_BAR;
    PG8_STAGE(PG8_SB(1, 0), cB + kstep, voffB); PG8_STAGE(PG8_SA(1, 0), cA + kstep, voffA); PG8_STAGE(PG8_SB(1, 1), cB + hstep + kstep, voffB);
    PG8_WAIT_V(6); PG8_BAR;
    for (;;) {
        const bool has_next = S.next(ui + 1, nxt);
        const char* nA = has_next ? (const char*)g.A + (size_t)nxt.pm * tstep : cA; const char* nB = has_next ? (const char*)g.Bt + (size_t)nxt.pn * tstep : cB;
        for (int t = 0; t < nt; t += 2) {
            const bool last = (t == nt - 2);
            const char* a1 = cA + (size_t)(t + 1) * kstep;
            const char* a2 = last ? nA : cA + (size_t)(t + 2) * kstep; const char* b2 = last ? nB : cB + (size_t)(t + 2) * kstep;
            const char* a3 = a2 + kstep; const char* b3 = b2 + kstep;
            PG8_LDB(B0, 0, 0); PG8_SCHED; PG8_LDA(At, 0, 0); PG8_STAGE(PG8_SA(1, 1), a1 + hstep, voffA);
            PG8_WAIT_L(8); PG8_BAR; PG8_WAIT_L(0); PG8_MMA(0, 0, At, B0); PG8_BAR; PG8_SCHED;
            PG8_LDB(B1, 0, 1); PG8_STAGE(PG8_SB(0, 0), b2, voffB);
            PG8_BAR; PG8_WAIT_L(0); PG8_MMA(0, 1, At, B1); PG8_BAR;
            PG8_LDA(At, 0, 1); PG8_STAGE(PG8_SA(0, 0), a2, voffA);
            PG8_BAR; PG8_WAIT_L(0); PG8_MMA(1, 0, At, B0); PG8_BAR; PG8_SCHED;
            PG8_STAGE(PG8_SB(0, 1), b2 + hstep, voffB);
            PG8_WAIT_V(6); PG8_BAR; PG8_MMA(1, 1, At, B1); PG8_BAR;
            PG8_LDB(B0, 1, 0); PG8_SCHED; PG8_LDA(At, 1, 0); PG8_STAGE(PG8_SA(0, 1), a2 + hstep, voffA);
            PG8_WAIT_L(8); PG8_BAR; PG8_WAIT_L(0); PG8_MMA(0, 0, At, B0); PG8_BAR; PG8_SCHED;
            PG8_LDB(B1, 1, 1); PG8_STAGE(PG8_SB(1, 0), b3, voffB);
            PG8_BAR; PG8_WAIT_L(0); PG8_MMA(0, 1, At, B1); PG8_BAR;
            PG8_LDA(At, 1, 1); PG8_STAGE(PG8_SA(1, 0), a3, voffA);
            PG8_BAR; PG8_WAIT_L(0); PG8_MMA(1, 0, At, B0); PG8_BAR; PG8_SCHED;
            PG8_STAGE(PG8_SB(1, 1), b3 + hstep, voffB);
            PG8_WAIT_V(6); PG8_BAR; PG8_MMA(1, 1, At, B1); PG8_BAR;
        }
        E(acc, cur, wr, wc, fr, fq);
        if (!has_next) break;
#pragma unroll
        for (int a = 0; a < 2; ++a)
#pragma unroll
            for (int b = 0; b < 2; ++b)
#pragma unroll
                for (int m = 0; m < 4; ++m)
#pragma unroll
                    for (int n = 0; n < 2; ++n) acc[a][b][m][n] = (f32x4){0.f, 0.f, 0.f, 0.f};
        cur = nxt; cA = nA; cB = nB; ++ui;
    }
    PG8_WAIT_V(0);
    if (wr == 0) PG8_BAR;
    PG8_BAR;
#undef PG8_SA
#undef PG8_SB
#undef PG8_STAGE
#undef PG8_LDA
#undef PG8_LDB
#undef PG8_MMA
#undef PG8_WAIT_V
#undef PG8_WAIT_L
#undef PG8_BAR
#undef PG8_SCHED
}

__device__ __forceinline__ void p0_transpose_item(const float* W, int K, int N, bf16_t* WT, LAS float* scr, int item, int lane) {
    const int nblk = N / 32, kb = item / nblk, nb = item % nblk, k0 = 64 * kb, n0 = 32 * nb;
#pragma unroll 8
    for (int i = 0; i < 32; ++i) { const int kk = 2 * i + (lane >> 5); scr[kk * 33 + (lane & 31)] = W[(size_t)(k0 + kk) * N + n0 + (lane & 31)]; }
    asm volatile("s_waitcnt lgkmcnt(0)" ::: "memory");
    const int c = lane & 7;
#pragma unroll
    for (int j = 0; j < 4; ++j) { const int n = (lane >> 3) + 8 * j; const LAS float* s = scr + (8 * c) * 33 + n;
        u32x4 o; o.x = cvt_pk_bf16(s[0 * 33], s[1 * 33]); o.y = cvt_pk_bf16(s[2 * 33], s[3 * 33]); o.z = cvt_pk_bf16(s[4 * 33], s[5 * 33]); o.w = cvt_pk_bf16(s[6 * 33], s[7 * 33]);
        *(u32x4*)(WT + (size_t)(n0 + n) * K + k0 + 8 * c) = o; }
    asm volatile("s_waitcnt lgkmcnt(0)" ::: "memory");
}

__device__ __forceinline__ void phase_prep(const Params& p, LAS unsigned char* lds, int gw, int NGW, int wave, int lane) {
    bf16_t* XN = (bf16_t*)(p.ws + WS_XN);
    f32x4 g[4];
#pragma unroll
    for (int j = 0; j < 4; ++j) g[j] = *((const f32x4*)p.norm_g + lane + 64 * j);
    for (int r = gw; r < MT; r += NGW) {
        const float* xrow = (r < MP) ? p.xp + (size_t)r * DM : p.xs + (size_t)(r - MP) * DM;
        f32x4 v[4]; float s = 0.f;
#pragma unroll
        for (int j = 0; j < 4; ++j) { v[j] = *((const f32x4*)xrow + lane + 64 * j); s += (v[j].x * v[j].x + v[j].y * v[j].y) + (v[j].z * v[j].z + v[j].w * v[j].w); }
        const float rinv = rsqrtf(wave_sum(s) * (1.0f / DM) + EPS);
        u32x2* o = (u32x2*)(XN + (size_t)r * DM) + lane;
#pragma unroll
        for (int j = 0; j < 4; ++j) { u32x2 w; w.x = cvt_pk_bf16(v[j].x * rinv * g[j].x, v[j].y * rinv * g[j].y); w.y = cvt_pk_bf16(v[j].z * rinv * g[j].z, v[j].w * rinv * g[j].w); o[64 * j] = w; }
    }
    LAS float* scr = (LAS float*)(lds + wave * 16384);
    constexpr int I_IN = (DM / 64) * (DIN / 32), I_OUT = (DM / 64) * (DM / 32), I_PW = 4 * (128 / 64) * (128 / 32);
    for (int it = gw; it < I_IN + I_OUT + I_PW; it += NGW) {
        int r = it;
        if (r < I_IN) { p0_transpose_item(p.w_in, DM, DIN, (bf16_t*)(p.ws + WS_WIN), scr, r, lane); continue; } r -= I_IN;
        if (r < I_OUT) { p0_transpose_item(p.w_out, DM, DM, (bf16_t*)(p.ws + WS_WOUT), scr, r, lane); continue; } r -= I_OUT;
        const int gidx = r >> 3; p0_transpose_item(p.pool_w + gidx * 16384, 128, 128, (bf16_t*)(p.ws + WS_PW) + gidx * 16384, scr, r & 7, lane);
    }
}

__device__ __forceinline__ void phase_mix(const Params& p, int gw, int NGW, int lane) {
    const bf16_t* PROJ = (const bf16_t*)(p.ws + WS_PROJ);
    bf16_t* YB = (bf16_t*)(p.ws + WS_YB);
    bf16_t* POOLED = (bf16_t*)(p.ws + WS_POOLED);
    const int c0 = lane * 8;
    for (int item = gw; item < 2 * MT; item += NGW) {
        const int r = item >> 1, part = item & 1;
        const bool samp = r >= MP;
        int b, t;
        if (!samp) { b = r >> 11; t = r & (SEQ - 1); } else { const int q = r - MP; b = q >> 2; t = q & 3; }
        const bf16_t* prow = PROJ + (size_t)r * DIN;
        if (part == 0) {
            const F8 Bv = ld_bf8(prow + c0), Cv = ld_bf8(prow + 512 + c0), Uv = ld_bf8(prow + 1024 + c0), Zv = ld_bf8(prow + 1536 + c0);
            F8 cu0, cu1, cu2;
#pragma unroll
            for (int i = 0; i < 8; ++i) cu0.v[i] = Cv.v[i] * Uv.v[i];
            if (t >= 1) { const F8 c1 = ld_bf8(prow - DIN + 512 + c0), u1 = ld_bf8(prow - DIN + 1024 + c0);
#pragma unroll
                for (int i = 0; i < 8; ++i) cu1.v[i] = c1.v[i] * u1.v[i]; }
            else if (samp) cu1 = ld_f8(p.sconv + ((size_t)b * 2 + 1) * DC + c0);
            else {
#pragma unroll
                for (int i = 0; i < 8; ++i) cu1.v[i] = 0.f; }
            if (t >= 2) { const F8 c2 = ld_bf8(prow - 2 * DIN + 512 + c0), u2 = ld_bf8(prow - 2 * DIN + 1024 + c0);
#pragma unroll
                for (int i = 0; i < 8; ++i) cu2.v[i] = c2.v[i] * u2.v[i]; }
            else if (samp) cu2 = ld_f8(p.sconv + ((size_t)b * 2 + t) * DC + c0);
            else {
#pragma unroll
                for (int i = 0; i < 8; ++i) cu2.v[i] = 0.f; }
            const F8 w0 = ld_f8(p.conv_w + c0), w1 = ld_f8(p.conv_w + DC + c0), w2 = ld_f8(p.conv_w + 2 * DC + c0);
            F8 ya;
#pragma unroll
            for (int i = 0; i < 8; ++i) { const float yc = w0.v[i] * cu2.v[i] + w1.v[i] * cu1.v[i] + w2.v[i] * cu0.v[i]; ya.v[i] = Bv.v[i] * yc * silu(Zv.v[i]); }
            st_bf8(YB + (size_t)r * DM + c0, ya);
            if (!samp) { if (t >= SEQ - 2) st_f8(p.out + O_CONVP + ((size_t)b * 2 + (t - (SEQ - 2))) * DC + c0, cu0); }
            else if (t >= 2) st_f8(p.out + O_CONVS + ((size_t)b * 2 + (t - 2)) * DC + c0, cu0);
        } else {
            const int gi = lane >> 4, w = 2 << gi;
            const F8 Vv = ld_bf8(prow + 2048 + c0);
            F8 s = Vv;
            for (int k = 1; k < w; ++k) {
                const int tt = t - k;
                if (tt >= 0) { const F8 x = ld_bf8(prow - (size_t)k * DIN + 2048 + c0);
#pragma unroll
                    for (int i = 0; i < 8; ++i) s.v[i] += x.v[i]; }
                else if (samp) { const F8 x = ld_f8(p.spool + ((size_t)b * 15 + (15 + tt)) * DPL + c0);
#pragma unroll
                    for (int i = 0; i < 8; ++i) s.v[i] += x.v[i]; }
            }
            const float cnt = samp ? (float)w : (float)((t + 1 < w) ? (t + 1) : w);
            const float ic = 1.0f / cnt;
            F8 pl;
#pragma unroll
            for (int i = 0; i < 8; ++i) pl.v[i] = s.v[i] * ic - Vv.v[i];
            st_bf8(POOLED + (size_t)r * DPL + c0, pl);
            if (!samp) { if (t >= SEQ - 15) st_f8(p.out + O_POOLP + ((size_t)b * 15 + (t - (SEQ - 15))) * DPL + c0, Vv); }
            else {
                st_f8(p.out + O_POOLS + ((size_t)b * 15 + 11 + t) * DPL + c0, Vv);
                for (int j = t; j < 11; j += 4) st_f8(p.out + O_POOLS + ((size_t)b * 15 + j) * DPL + c0, ld_f8(p.spool + ((size_t)b * 15 + 4 + j) * DPL + c0));
            }
        }
    }
}

__device__ __forceinline__ void phase_poolgemm(const Params& p, int gw, int NGW, int lane) {
    const bf16_t* PROJ = (const bf16_t*)(p.ws + WS_PROJ);
    const bf16_t* POOLED = (const bf16_t*)(p.ws + WS_POOLED);
    const bf16_t* PWT = (const bf16_t*)(p.ws + WS_PW);
    bf16_t* YB = (bf16_t*)(p.ws + WS_YB);
    const int fr = lane & 15, fq = lane >> 4;
    for (int item = gw; item < (MT / 16) * 4; item += NGW) {
        const int rb = item >> 2, gi = item & 3;
        const int row = rb * 16 + fr;
        bf16x8 af[4];
#pragma unroll
        for (int ks = 0; ks < 4; ++ks) af[ks] = *(const bf16x8*)(POOLED + (size_t)row * DPL + gi * 128 + ks * 32 + fq * 8);
#pragma unroll 2
        for (int nb = 0; nb < 8; ++nb) {
            f32x4 acc = (f32x4){0.f, 0.f, 0.f, 0.f};
#pragma unroll
            for (int ks = 0; ks < 4; ++ks) {
                const bf16x8 bfrag = *(const bf16x8*)(PWT + (size_t)gi * 16384 + (nb * 16 + fr) * 128 + ks * 32 + fq * 8);
                acc = __builtin_amdgcn_mfma_f32_16x16x32_bf16(bfrag, af[ks], acc, 0, 0, 0);
            }
            const int col = gi * 128 + nb * 16 + fq * 4;
            const f32x4 sc = *(const f32x4*)(p.pool_scale + col);
            const u32x2 zw = *(const u32x2*)(PROJ + (size_t)row * DIN + 2560 + col);
            const float y0 = acc[0] * sc[0] * silu(bf_lo(zw.x)), y1 = acc[1] * sc[1] * silu(bf_hi(zw.x));
            const float y2 = acc[2] * sc[2] * silu(bf_lo(zw.y)), y3 = acc[3] * sc[3] * silu(bf_hi(zw.y));
            u32x2 o; o.x = cvt_pk_bf16(y0, y1); o.y = cvt_pk_bf16(y2, y3);
            *(u32x2*)(YB + (size_t)row * DM + 512 + col) = o;
        }
    }
}

__device__ __forceinline__ void phase_final(const Params& p, int gw, int NGW, int lane) {
    f32x4 g[4];
#pragma unroll
    for (int j = 0; j < 4; ++j) g[j] = *((const f32x4*)p.final_g + lane + 64 * j);
    for (int r = gw; r < MT; r += NGW) {
        f32x4* row = (f32x4*)(p.out + (size_t)r * DM) + lane;
        f32x4 v[4]; float s = 0.f;
#pragma unroll
        for (int j = 0; j < 4; ++j) { v[j] = row[64 * j]; s += (v[j].x * v[j].x + v[j].y * v[j].y) + (v[j].z * v[j].z + v[j].w * v[j].w); }
        const float rinv = rsqrtf(wave_sum(s) * (1.0f / DM) + EPS);
#pragma unroll
        for (int j = 0; j < 4; ++j) row[64 * j] = v[j] * rinv * g[j];
    }
}

__global__ void __launch_bounds__(512, 2) fwd_megakernel(Params p) {
    extern __shared__ __attribute__((aligned(16))) unsigned char shm[];
    LAS unsigned char* lds = (LAS unsigned char*)shm;
    cg::grid_group grid = cg::this_grid();
    const int tid = threadIdx.x, wave = tid >> 6, lane = tid & 63;
    const int gw = blockIdx.x * 8 + wave, NGW = gridDim.x * 8;

    phase_prep(p, lds, gw, NGW, wave, lane);
    grid.sync();
    { Gemm g{(const bf16_t*)(p.ws + WS_XN), (const bf16_t*)(p.ws + WS_WIN), MT, DIN, DM};
      StaticOrder S; S.init(MT, DIN, (int)gridDim.x, (int)blockIdx.x);
      EpiProj E{(bf16_t*)(p.ws + WS_PROJ)};
      gemm_phase(lds, g, S, E); }
    grid.sync();
    phase_mix(p, gw, NGW, lane);
    grid.sync();
    phase_poolgemm(p, gw, NGW, lane);
    grid.sync();
    { Gemm g{(const bf16_t*)(p.ws + WS_YB), (const bf16_t*)(p.ws + WS_WOUT), MT, DM, DM};
      StaticOrder S; S.init(MT, DM, (int)gridDim.x, (int)blockIdx.x);
      EpiOut E{p.out, p.xp, p.xs};
      gemm_phase(lds, g, S, E); }
    grid.sync();
    phase_final(p, gw, NGW, lane);
}

extern "C" void kernel_launch(void* const* d_in, const int* in_sizes, int n_in, void* d_out, int out_size, void* d_ws, size_t ws_size, hipStream_t stream) {
    static int grid_blocks = 0;
    if (!grid_blocks) {
        int dev = 0, cus = 0, per_cu = 0;
        hipGetDevice(&dev);
        hipDeviceGetAttribute(&cus, hipDeviceAttributeMultiprocessorCount, dev);
        if (hipFuncSetAttribute((const void*)fwd_megakernel, hipFuncAttributeMaxDynamicSharedMemorySize, LDS_BYTES) != hipSuccess) fprintf(stderr, "hipFuncSetAttribute failed\n");
        hipOccupancyMaxActiveBlocksPerMultiprocessor(&per_cu, (const void*)fwd_megakernel, 512, LDS_BYTES);
        if (per_cu < 1) { fprintf(stderr, "occupancy query says %d blocks/CU\n", per_cu); per_cu = 1; }
        grid_blocks = cus * per_cu;
        (void)hipGetLastError();
    }
    Params p{};
    p.xp = (const float*)d_in[0]; p.xs = (const float*)d_in[1]; p.sconv = (const float*)d_in[2]; p.spool = (const float*)d_in[3];
    p.norm_g = (const float*)d_in[4]; p.w_in = (const float*)d_in[5]; p.conv_w = (const float*)d_in[6]; p.pool_w = (const float*)d_in[7];
    p.pool_scale = (const float*)d_in[8]; p.w_out = (const float*)d_in[9]; p.final_g = (const float*)d_in[10];
    p.out = (float*)d_out; p.ws = (unsigned char*)d_ws;
    void* args[] = {&p};
    hipError_t e = hipLaunchCooperativeKernel((void*)fwd_megakernel, dim3(grid_blocks), dim3(512), args, LDS_BYTES, stream);
    if (e != hipSuccess) fprintf(stderr, "cooperative launch failed: %s (grid %d)\n", hipGetErrorString(e), grid_blocks);
}
```

```cpp
#include <hip/hip_runtime.h>
#include <hip/hip_cooperative_groups.h>
#include <cstdio>
namespace cg = cooperative_groups;

#define LAS __attribute__((address_space(3)))
typedef unsigned short bf16_t;
typedef short bf16x8 __attribute__((ext_vector_type(8)));
typedef float f32x4 __attribute__((ext_vector_type(4)));
typedef unsigned u32x4 __attribute__((ext_vector_type(4)));
typedef unsigned u32x2 __attribute__((ext_vector_type(2)));

constexpr int MP = 16384, MS = 512, MT = MP + MS, DM = 1024, DIN = 3072, DC = 512, DPL = 512;
constexpr int SEQ = 2048, DSEQ = 4;
constexpr float EPS = 1e-6f;
constexpr int BM = 256, BK = 64, HALF = 128, HTB = HALF * BK * 2, STAGE_BYTES = 8 * HTB, NXCD = 8, WGM = 8;
constexpr int LDS_BYTES = STAGE_BYTES + 16;

constexpr size_t WS_BAR = 0;
constexpr size_t WS_XN = 16384;
constexpr size_t WS_WIN = WS_XN + (size_t)MT * DM * 2;
constexpr size_t WS_WOUT = WS_WIN + (size_t)DIN * DM * 2;
constexpr size_t WS_PW = WS_WOUT + (size_t)DM * DM * 2;
constexpr size_t WS_PROJ = WS_PW + (size_t)4 * 128 * 128 * 2;
constexpr size_t WS_YB = WS_PROJ + (size_t)MT * DIN * 2;
constexpr size_t WS_POOLED = WS_YB + (size_t)MT * DM * 2;
constexpr size_t WS_END = WS_POOLED + (size_t)MT * DPL * 2;

constexpr size_t O_Y = 0;
constexpr size_t O_CONVP = (size_t)MT * DM;
constexpr size_t O_POOLP = O_CONVP + 8 * 2 * 512;
constexpr size_t O_CONVS = O_POOLP + 8 * 15 * 512;
constexpr size_t O_POOLS = O_CONVS + 128 * 2 * 512;

struct Params {
    const float *xp, *xs, *sconv, *spool, *norm_g, *w_in, *conv_w, *pool_w, *pool_scale, *w_out, *final_g;
    float* out;
    unsigned char* ws;
    unsigned long long never;
};

__device__ __forceinline__ unsigned cvt_pk_bf16(float lo, float hi) { unsigned r; asm volatile("v_cvt_pk_bf16_f32 %0, %1, %2" : "=v"(r) : "v"(lo), "v"(hi)); return r; }
__device__ __forceinline__ float bf_lo(unsigned w) { return __uint_as_float(w << 16); }
__device__ __forceinline__ float bf_hi(unsigned w) { return __uint_as_float(w & 0xffff0000u); }
__device__ __forceinline__ float wave_sum(float v) {
#pragma unroll
    for (int o = 1; o < 64; o <<= 1) v += __shfl_xor(v, o);
    return v;
}
__device__ __forceinline__ float silu(float z) { return z / (1.0f + __expf(-z)); }

struct F8 { float v[8]; };
__device__ __forceinline__ F8 ld_bf8(const bf16_t* p) {
    const u32x4 w = *(const u32x4*)p; F8 r;
    r.v[0] = bf_lo(w.x); r.v[1] = bf_hi(w.x); r.v[2] = bf_lo(w.y); r.v[3] = bf_hi(w.y);
    r.v[4] = bf_lo(w.z); r.v[5] = bf_hi(w.z); r.v[6] = bf_lo(w.w); r.v[7] = bf_hi(w.w); return r;
}
__device__ __forceinline__ F8 ld_f8(const float* p) {
    const f32x4 a = *(const f32x4*)p, b = *(const f32x4*)(p + 4); F8 r;
    r.v[0] = a.x; r.v[1] = a.y; r.v[2] = a.z; r.v[3] = a.w; r.v[4] = b.x; r.v[5] = b.y; r.v[6] = b.z; r.v[7] = b.w; return r;
}
__device__ __forceinline__ void st_f8(float* p, const F8& r) {
    *(f32x4*)p = (f32x4){r.v[0], r.v[1], r.v[2], r.v[3]}; *(f32x4*)(p + 4) = (f32x4){r.v[4], r.v[5], r.v[6], r.v[7]};
}
__device__ __forceinline__ void st_bf8(bf16_t* p, const F8& r) {
    u32x4 w; w.x = cvt_pk_bf16(r.v[0], r.v[1]); w.y = cvt_pk_bf16(r.v[2], r.v[3]); w.z = cvt_pk_bf16(r.v[4], r.v[5]); w.w = cvt_pk_bf16(r.v[6], r.v[7]);
    *(u32x4*)p = w;
}


#define XB_TMO      128
#define XB_XCNT(j)  (256  + 64 * (j))
#define XB_XSUB(j)  (1280 + 64 * (j))
#define XB_XGEN(j)  (2304 + 64 * (j))
#define XB_TOP      3328
#define XB_TOPGEN   3392
#define XCD_BAR_WORDS 3456
#define XB_SPIN_CAP (1u << 18)
__device__ __forceinline__ unsigned xb_ld(unsigned* p)              { return __hip_atomic_load(p, __ATOMIC_RELAXED, __HIP_MEMORY_SCOPE_AGENT); }
__device__ __forceinline__ unsigned xb_add(unsigned* p, unsigned v) { return __hip_atomic_fetch_add(p, v, __ATOMIC_RELAXED, __HIP_MEMORY_SCOPE_AGENT); }
__device__ __forceinline__ unsigned xb_xcc_id() { return (unsigned)__builtin_amdgcn_s_getreg((3 << 11) | 20) & 0xFu; }
#define XB_SPIN(cond, bar) do { unsigned _sp = 0; while (cond) { __builtin_amdgcn_s_sleep(1); \
    if ((++_sp & 255u) == 0u) { if (xb_ld(&(bar)[XB_TMO])) break; if (_sp > XB_SPIN_CAP) { atomicAdd(&(bar)[XB_TMO], 1u); break; } } } } while (0)
struct XcdBarrier { unsigned* bar; unsigned x; volatile LAS unsigned* st; };
__device__ __forceinline__ XcdBarrier xcd_barrier_post(unsigned* bar, volatile LAS unsigned* st) {
    XcdBarrier b; b.bar = bar; b.x = xb_xcc_id(); b.st = st;
    if (threadIdx.x == 0) (void)xb_add(&bar[XB_XCNT(b.x)], 1u);
    return b;
}
__device__ __forceinline__ void xcd_barrier_complete(unsigned* bar, unsigned x, unsigned& nloc, unsigned& nx) {
    const unsigned G = gridDim.x * gridDim.y * gridDim.z;
    unsigned sum, cnt, mine, sp = 0u;
    for (;;) {
        sum = 0u; cnt = 0u; mine = 0u;
#pragma unroll
        for (unsigned j = 0; j < 16; ++j) { const unsigned c = xb_ld(&bar[XB_XCNT(j)]); sum += c; cnt += (c > 0u) ? 1u : 0u; mine = (j == x) ? c : mine; }
        if (sum == G) break;
        __builtin_amdgcn_s_sleep(1);
        if ((++sp & 255u) == 0u) { if (xb_ld(&bar[XB_TMO])) break; if (sp > XB_SPIN_CAP) { atomicAdd(&bar[XB_TMO], 1u); break; } }
    }
    nloc = mine > 0u ? mine : 1u; nx = cnt > 0u ? cnt : 1u;
}
__device__ __forceinline__ void xcd_barrier(const XcdBarrier& b) {
    asm volatile("s_waitcnt vmcnt(0)" ::: "memory");
    __syncthreads();
    if (threadIdx.x == 0) {
        unsigned* bar = b.bar;
        __builtin_amdgcn_s_waitcnt(0);
        unsigned nloc = b.st[0], nx = b.st[1];
        if (nloc == 0u) { xcd_barrier_complete(bar, b.x, nloc, nx); b.st[0] = nloc; b.st[1] = nx; }
        const unsigned old = xb_add(&bar[XB_XSUB(b.x)], 1u);
        const unsigned gen = old / nloc;
        if (old + 1u == (gen + 1u) * nloc) {
            __builtin_amdgcn_fence(__ATOMIC_RELEASE, "agent");
            asm volatile("s_waitcnt vmcnt(0)" ::: "memory");
            const unsigned og = xb_add(&bar[XB_TOP], 1u);
            const unsigned tg = og / nx;
            if (og + 1u == (tg + 1u) * nx) xb_add(&bar[XB_TOPGEN], 1u);
            else XB_SPIN(xb_ld(&bar[XB_TOPGEN]) == tg, bar);
            __builtin_amdgcn_fence(__ATOMIC_ACQUIRE, "agent");
            xb_add(&bar[XB_XGEN(b.x)], 1u);
            asm volatile("s_waitcnt vmcnt(0)" ::: "memory");
        } else {
            XB_SPIN(xb_ld(&bar[XB_XGEN(b.x)]) == gen, bar);
            __builtin_amdgcn_fence(__ATOMIC_ACQUIRE, "agent");
            asm volatile("s_waitcnt vmcnt(0)" ::: "memory");
        }
    }
    __syncthreads();
}

__host__ __device__ __forceinline__ int lds_byte(int r, int c) { const int st = (r >> 4) * 2 + (c >> 5), rr = r & 15, cc = c & 31, ob = rr * 64 + cc * 2; return st * 1024 + (ob ^ (((ob >> 9) & 1) << 5)); }
__host__ __device__ __forceinline__ void stage_rc(int b, int& R, int& C) { const int st = b / 1024, sb = b % 1024, swz = sb ^ (((sb >> 9) & 1) << 5); R = (st >> 1) * 16 + swz / 64; C = (st & 1) * 32 + (swz % 64) / 2; }
__host__ __device__ __forceinline__ int perm32(int rho) { const int n = rho >> 4, i = rho & 15; return 8 * (i >> 2) + 4 * n + (i & 3); }

struct Unit { int pm, pn; };
struct Gemm { const bf16_t* A; const bf16_t* Bt; int M, N, K; };

struct StaticOrder {
    int nM, nN, nwg, G, c;
    __device__ void init(int M, int N, int G_, int c_) { nM = M / BM; nN = N / BM; nwg = nM * nN; G = G_; c = c_; }
    __device__ bool next(int i, Unit& u) const {
        const long L = (long)i * G + c; if (L >= nwg) return false;
        int wgid = (int)L; { const int q = nwg / NXCD, r = nwg % NXCD, xcd = wgid % NXCD, off = wgid / NXCD; wgid = (xcd < r ? xcd * (q + 1) : r * (q + 1) + (xcd - r) * q) + off; }
        const int nig = WGM * nN, gid = wgid / nig, fm = gid * WGM, gsz = (nM - fm) < WGM ? (nM - fm) : WGM;
        u.pm = fm + ((wgid % nig) % gsz); u.pn = (wgid % nig) / gsz; return true;
    }
};

struct EpiProj {
    static constexpr bool PERM = true;
    bf16_t* O;
    __device__ __forceinline__ void operator()(const f32x4 (&acc)[2][2][4][2], const Unit& u, int wr, int wc, int fr, int fq) const {
        const int row0 = u.pm * BM + wr * 64 + fr, col0 = u.pn * BM + wc * 32 + 8 * fq;
#pragma unroll
        for (int ai = 0; ai < 2; ++ai)
#pragma unroll
            for (int m = 0; m < 4; ++m) { bf16_t* rowp = O + (size_t)(row0 + ai * HALF + m * 16) * DIN + col0;
#pragma unroll
                for (int bj = 0; bj < 2; ++bj) { const f32x4 v0 = acc[ai][bj][m][0], v1 = acc[ai][bj][m][1];
                    u32x4 w; w.x = cvt_pk_bf16(v0[0], v0[1]); w.y = cvt_pk_bf16(v0[2], v0[3]); w.z = cvt_pk_bf16(v1[0], v1[1]); w.w = cvt_pk_bf16(v1[2], v1[3]);
                    *(u32x4*)(rowp + bj * HALF) = w; } }
    }
};
struct EpiOut {
    static constexpr bool PERM = false;
    float* out; const float* xp; const float* xs;
    __device__ __forceinline__ void operator()(const f32x4 (&acc)[2][2][4][2], const Unit& u, int wr, int wc, int fr, int fq) const {
        const int row0 = u.pm * BM + wr * 64 + fr, col0 = u.pn * BM + wc * 32 + 4 * fq;
        const float* xbase = (u.pm * BM < MP) ? xp : (xs - (size_t)MP * DM);
#pragma unroll
        for (int ai = 0; ai < 2; ++ai)
#pragma unroll
            for (int m = 0; m < 4; ++m) { const size_t ro = (size_t)(row0 + ai * HALF + m * 16) * DM + col0; float* rowp = out + ro; const float* xr = xbase + ro;
#pragma unroll
                for (int bj = 0; bj < 2; ++bj)
#pragma unroll
                    for (int n = 0; n < 2; ++n) *(f32x4*)(rowp + bj * HALF + n * 16) = acc[ai][bj][m][n] + *(const f32x4*)(xr + bj * HALF + n * 16); }
    }
};

template <class Epi, class Sched>
__device__ __forceinline__ void gemm_phase(LAS unsigned char* lds, const Gemm g, const Sched& S, const Epi& E) {
    const int tid = threadIdx.x, wid = __builtin_amdgcn_readfirstlane(tid >> 6), lane = tid & 63, wr = wid >> 2, wc = wid & 3, fr = lane & 15, fq = lane >> 4;
    const int K = g.K, nt = K / BK;
    unsigned voffA[2], voffB[2];
#pragma unroll
    for (int i = 0; i < 2; ++i) { int R, C; stage_rc(tid * 16 + i * 8192, R, C); const int Rb = Epi::PERM ? ((R & ~31) + perm32(R & 31)) : R;
        voffA[i] = (unsigned)(R * K + C) * 2u; voffB[i] = (unsigned)(Rb * K + C) * 2u; }
    const size_t kstep = (size_t)(BK * 2);
    const size_t hstep = (size_t)HALF * K * 2;
    const size_t tstep = 2 * hstep;
    const unsigned ldsw = (unsigned)wid * 1024u;
    const int aoff = lds_byte(wr * 64 + fr, fq * 8), boff = lds_byte(wc * 32 + fr, fq * 8);
#define PG8_SA(b, h) (((b) * 2 + (h)) * HTB)
#define PG8_SB(b, h) ((4 + (b) * 2 + (h)) * HTB)
#define PG8_STAGE(bufoff, gbase, voff) do { _Pragma("unroll") for (int _i = 0; _i < 2; ++_i) \
        __builtin_amdgcn_global_load_lds((const unsigned*)((const char*)(gbase) + (voff)[_i]), (LAS unsigned*)(lds + (bufoff) + ldsw + _i * 8192), 16, 0, 0); } while (0)
#define PG8_LDA(dst, b, h) do { _Pragma("unroll") for (int m = 0; m < 4; ++m) _Pragma("unroll") for (int k = 0; k < 2; ++k) dst[m][k] = *(const LAS bf16x8*)(lds + PG8_SA(b, h) + aoff + m * 2048 + k * 1024); } while (0)
#define PG8_LDB(dst, b, h) do { _Pragma("unroll") for (int n = 0; n < 2; ++n) _Pragma("unroll") for (int k = 0; k < 2; ++k) dst[n][k] = *(const LAS bf16x8*)(lds + PG8_SB(b, h) + boff + n * 2048 + k * 1024); } while (0)
#define PG8_MMA(ai, bj, At, Bt) do { __builtin_amdgcn_s_setprio(1); _Pragma("unroll") for (int m = 0; m < 4; ++m) _Pragma("unroll") for (int n = 0; n < 2; ++n) _Pragma("unroll") for (int k = 0; k < 2; ++k) \
        acc[ai][bj][m][n] = __builtin_amdgcn_mfma_f32_16x16x32_bf16(Bt[n][k], At[m][k], acc[ai][bj][m][n], 0, 0, 0); __builtin_amdgcn_s_setprio(0); } while (0)
#define PG8_WAIT_V(n) asm volatile("s_waitcnt vmcnt(" #n ")" ::: "memory")
#define PG8_WAIT_L(n) asm volatile("s_waitcnt lgkmcnt(" #n ")" ::: "memory")
#define PG8_BAR __builtin_amdgcn_s_barrier()
#define PG8_SCHED __builtin_amdgcn_sched_barrier(0)
    Unit cur, nxt; int ui = 0;
    if (!S.next(0, cur)) return;
    f32x4 acc[2][2][4][2];
#pragma unroll
    for (int a = 0; a < 2; ++a)
#pragma unroll
        for (int b = 0; b < 2; ++b)
#pragma unroll
            for (int m = 0; m < 4; ++m)
#pragma unroll
                for (int n = 0; n < 2; ++n) acc[a][b][m][n] = (f32x4){0.f, 0.f, 0.f, 0.f};
    bf16x8 At[4][2], B0[2][2], B1[2][2];
    const char* cA = (const char*)g.A + (size_t)cur.pm * tstep; const char* cB = (const char*)g.Bt + (size_t)cur.pn * tstep;
    PG8_STAGE(PG8_SB(0, 0), cB, voffB); PG8_STAGE(PG8_SA(0, 0), cA, voffA); PG8_STAGE(PG8_SB(0, 1), cB + hstep, voffB); PG8_STAGE(PG8_SA(0, 1), cA + hstep, voffA);
    if (wr == 1) PG8_BAR;
    PG8_WAIT_V(4); PG8_BAR;
    PG8_STAGE(PG8_SB(1, 0), cB + kstep, voffB); PG8_STAGE(PG8_SA(1, 0), cA + kstep, voffA); PG8_STAGE(PG8_SB(1, 1), cB + hstep + kstep, voffB);
    PG8_WAIT_V(6); PG8_BAR;
    for (;;) {
        const bool has_next = S.next(ui + 1, nxt);
        const char* nA = has_next ? (const char*)g.A + (size_t)nxt.pm * tstep : cA; const char* nB = has_next ? (const char*)g.Bt + (size_t)nxt.pn * tstep : cB;
        for (int t = 0; t < nt; t += 2) {
            const bool last = (t == nt - 2);
            const char* a1 = cA + (size_t)(t + 1) * kstep;
            const char* a2 = last ? nA : cA + (size_t)(t + 2) * kstep; const char* b2 = last ? nB : cB + (size_t)(t + 2) * kstep;
            const char* a3 = a2 + kstep; const char* b3 = b2 + kstep;
            PG8_LDB(B0, 0, 0); PG8_SCHED; PG8_LDA(At, 0, 0); PG8_STAGE(PG8_SA(1, 1), a1 + hstep, voffA);
            PG8_WAIT_L(8); PG8_BAR; PG8_WAIT_L(0); PG8_MMA(0, 0, At, B0); PG8_BAR; PG8_SCHED;
            PG8_LDB(B1, 0, 1); PG8_STAGE(PG8_SB(0, 0), b2, voffB);
            PG8_BAR; PG8_WAIT_L(0); PG8_MMA(0, 1, At, B1); PG8_BAR;
            PG8_LDA(At, 0, 1); PG8_STAGE(PG8_SA(0, 0), a2, voffA);
            PG8_BAR; PG8_WAIT_L(0); PG8_MMA(1, 0, At, B0); PG8_BAR; PG8_SCHED;
            PG8_STAGE(PG8_SB(0, 1), b2 + hstep, voffB);
            PG8_WAIT_V(6); PG8_BAR; PG8_MMA(1, 1, At, B1); PG8_BAR;
            PG8_LDB(B0, 1, 0); PG8_SCHED; PG8_LDA(At, 1, 0); PG8_STAGE(PG8_SA(0, 1), a2 + hstep, voffA);
            PG8_WAIT_L(8); PG8_BAR; PG8_WAIT_L(0); PG8_MMA(0, 0, At, B0); PG8_BAR; PG8_SCHED;
            PG8_LDB(B1, 1, 1); PG8_STAGE(PG8_SB(1, 0), b3, voffB);
            PG8_BAR; PG8_WAIT_L(0); PG8_MMA(0, 1, At, B1); PG8_BAR;
            PG8_LDA(At, 1, 1); PG8_STAGE(PG8_SA(1, 0), a3, voffA);
            PG8_BAR; PG8_WAIT_L(0); PG8_MMA(1, 0, At, B0); PG8_BAR; PG8_SCHED;
            PG8_STAGE(PG8_SB(1, 1), b3 + hstep, voffB);
            PG8_WAIT_V(6); PG8_BAR; PG8_MMA(1, 1, At, B1); PG8_BAR;
        }
        E(acc, cur, wr, wc, fr, fq);
        if (!has_next) break;
#pragma unroll
        for (int a = 0; a < 2; ++a)
#pragma unroll
            for (int b = 0; b < 2; ++b)
#pragma unroll
                for (int m = 0; m < 4; ++m)
#pragma unroll
                    for (int n = 0; n < 2; ++n) acc[a][b][m][n] = (f32x4){0.f, 0.f, 0.f, 0.f};
        cur = nxt; cA = nA; cB = nB; ++ui;
    }
    PG8_WAIT_V(0);
    if (wr == 0) PG8_BAR;
    PG8_BAR;
#undef PG8_SA
#undef PG8_SB
#undef PG8_STAGE
#undef PG8_LDA
#undef PG8_LDB
#undef PG8_MMA
#undef PG8_WAIT_V
#undef PG8_WAIT_L
#undef PG8_BAR
#undef PG8_SCHED
}

__device__ __forceinline__ void p0_transpose_item(const float* W, int K, int N, bf16_t* WT, LAS float* scr, int item, int lane) {
    const int nblk = N / 32, kb = item / nblk, nb = item % nblk, k0 = 64 * kb, n0 = 32 * nb;
#pragma unroll 8
    for (int i = 0; i < 32; ++i) { const int kk = 2 * i + (lane >> 5); scr[kk * 33 + (lane & 31)] = W[(size_t)(k0 + kk) * N + n0 + (lane & 31)]; }
    asm volatile("s_waitcnt lgkmcnt(0)" ::: "memory");
    const int c = lane & 7;
#pragma unroll
    for (int j = 0; j < 4; ++j) { const int n = (lane >> 3) + 8 * j; const LAS float* s = scr + (8 * c) * 33 + n;
        u32x4 o; o.x = cvt_pk_bf16(s[0 * 33], s[1 * 33]); o.y = cvt_pk_bf16(s[2 * 33], s[3 * 33]); o.z = cvt_pk_bf16(s[4 * 33], s[5 * 33]); o.w = cvt_pk_bf16(s[6 * 33], s[7 * 33]);
        *(u32x4*)(WT + (size_t)(n0 + n) * K + k0 + 8 * c) = o; }
    asm volatile("s_waitcnt lgkmcnt(0)" ::: "memory");
}

__device__ __forceinline__ void phase_prep(const Params& p, LAS unsigned char* lds, int gw, int NGW, int wave, int lane) {
    bf16_t* XN = (bf16_t*)(p.ws + WS_XN);
    f32x4 g[4];
#pragma unroll
    for (int j = 0; j < 4; ++j) g[j] = *((const f32x4*)p.norm_g + lane + 64 * j);
    for (int r = gw; r < MT; r += NGW) {
        const float* xrow = (r < MP) ? p.xp + (size_t)r * DM : p.xs + (size_t)(r - MP) * DM;
        f32x4 v[4]; float s = 0.f;
#pragma unroll
        for (int j = 0; j < 4; ++j) { v[j] = *((const f32x4*)xrow + lane + 64 * j); s += (v[j].x * v[j].x + v[j].y * v[j].y) + (v[j].z * v[j].z + v[j].w * v[j].w); }
        const float rinv = rsqrtf(wave_sum(s) * (1.0f / DM) + EPS);
        u32x2* o = (u32x2*)(XN + (size_t)r * DM) + lane;
#pragma unroll
        for (int j = 0; j < 4; ++j) { u32x2 w; w.x = cvt_pk_bf16(v[j].x * rinv * g[j].x, v[j].y * rinv * g[j].y); w.y = cvt_pk_bf16(v[j].z * rinv * g[j].z, v[j].w * rinv * g[j].w); o[64 * j] = w; }
    }
    LAS float* scr = (LAS float*)(lds + wave * 16384);
    constexpr int I_IN = (DM / 64) * (DIN / 32), I_OUT = (DM / 64) * (DM / 32), I_PW = 4 * (128 / 64) * (128 / 32);
    for (int it = gw; it < I_IN + I_OUT + I_PW; it += NGW) {
        int r = it;
        if (r < I_IN) { p0_transpose_item(p.w_in, DM, DIN, (bf16_t*)(p.ws + WS_WIN), scr, r, lane); continue; } r -= I_IN;
        if (r < I_OUT) { p0_transpose_item(p.w_out, DM, DM, (bf16_t*)(p.ws + WS_WOUT), scr, r, lane); continue; } r -= I_OUT;
        const int gidx = r >> 3; p0_transpose_item(p.pool_w + gidx * 16384, 128, 128, (bf16_t*)(p.ws + WS_PW) + gidx * 16384, scr, r & 7, lane);
    }
}

__device__ __forceinline__ void phase_mix(const Params& p, int gw, int NGW, int lane) {
    const bf16_t* PROJ = (const bf16_t*)(p.ws + WS_PROJ);
    bf16_t* YB = (bf16_t*)(p.ws + WS_YB);
    bf16_t* POOLED = (bf16_t*)(p.ws + WS_POOLED);
    const int c0 = lane * 8;
    for (int item = gw; item < 2 * MT; item += NGW) {
        const int r = item >> 1, part = item & 1;
        const bool samp = r >= MP;
        int b, t;
        if (!samp) { b = r >> 11; t = r & (SEQ - 1); } else { const int q = r - MP; b = q >> 2; t = q & 3; }
        const bf16_t* prow = PROJ + (size_t)r * DIN;
        if (part == 0) {
            const F8 Bv = ld_bf8(prow + c0), Cv = ld_bf8(prow + 512 + c0), Uv = ld_bf8(prow + 1024 + c0), Zv = ld_bf8(prow + 1536 + c0);
            F8 cu0, cu1, cu2;
#pragma unroll
            for (int i = 0; i < 8; ++i) cu0.v[i] = Cv.v[i] * Uv.v[i];
            if (t >= 1) { const F8 c1 = ld_bf8(prow - DIN + 512 + c0), u1 = ld_bf8(prow - DIN + 1024 + c0);
#pragma unroll
                for (int i = 0; i < 8; ++i) cu1.v[i] = c1.v[i] * u1.v[i]; }
            else if (samp) cu1 = ld_f8(p.sconv + ((size_t)b * 2 + 1) * DC + c0);
            else {
#pragma unroll
                for (int i = 0; i < 8; ++i) cu1.v[i] = 0.f; }
            if (t >= 2) { const F8 c2 = ld_bf8(prow - 2 * DIN + 512 + c0), u2 = ld_bf8(prow - 2 * DIN + 1024 + c0);
#pragma unroll
                for (int i = 0; i < 8; ++i) cu2.v[i] = c2.v[i] * u2.v[i]; }
            else if (samp) cu2 = ld_f8(p.sconv + ((size_t)b * 2 + t) * DC + c0);
            else {
#pragma unroll
                for (int i = 0; i < 8; ++i) cu2.v[i] = 0.f; }
            const F8 w0 = ld_f8(p.conv_w + c0), w1 = ld_f8(p.conv_w + DC + c0), w2 = ld_f8(p.conv_w + 2 * DC + c0);
            F8 ya;
#pragma unroll
            for (int i = 0; i < 8; ++i) { const float yc = w0.v[i] * cu2.v[i] + w1.v[i] * cu1.v[i] + w2.v[i] * cu0.v[i]; ya.v[i] = Bv.v[i] * yc * silu(Zv.v[i]); }
            st_bf8(YB + (size_t)r * DM + c0, ya);
            if (!samp) { if (t >= SEQ - 2) st_f8(p.out + O_CONVP + ((size_t)b * 2 + (t - (SEQ - 2))) * DC + c0, cu0); }
            else if (t >= 2) st_f8(p.out + O_CONVS + ((size_t)b * 2 + (t - 2)) * DC + c0, cu0);
        } else {
            const int gi = lane >> 4, w = 2 << gi;
            const F8 Vv = ld_bf8(prow + 2048 + c0);
            F8 s = Vv;
            for (int k = 1; k < w; ++k) {
                const int tt = t - k;
                if (tt >= 0) { const F8 x = ld_bf8(prow - (size_t)k * DIN + 2048 + c0);
#pragma unroll
                    for (int i = 0; i < 8; ++i) s.v[i] += x.v[i]; }
                else if (samp) { const F8 x = ld_f8(p.spool + ((size_t)b * 15 + (15 + tt)) * DPL + c0);
#pragma unroll
                    for (int i = 0; i < 8; ++i) s.v[i] += x.v[i]; }
            }
            const float cnt = samp ? (float)w : (float)((t + 1 < w) ? (t + 1) : w);
            const float ic = 1.0f / cnt;
            F8 pl;
#pragma unroll
            for (int i = 0; i < 8; ++i) pl.v[i] = s.v[i] * ic - Vv.v[i];
            st_bf8(POOLED + (size_t)r * DPL + c0, pl);
            if (!samp) { if (t >= SEQ - 15) st_f8(p.out + O_POOLP + ((size_t)b * 15 + (t - (SEQ - 15))) * DPL + c0, Vv); }
            else {
                st_f8(p.out + O_POOLS + ((size_t)b * 15 + 11 + t) * DPL + c0, Vv);
                for (int j = t; j < 11; j += 4) st_f8(p.out + O_POOLS + ((size_t)b * 15 + j) * DPL + c0, ld_f8(p.spool + ((size_t)b * 15 + 4 + j) * DPL + c0));
            }
        }
    }
}

__device__ __forceinline__ void phase_poolgemm(const Params& p, int gw, int NGW, int lane) {
    const bf16_t* PROJ = (const bf16_t*)(p.ws + WS_PROJ);
    const bf16_t* POOLED = (const bf16_t*)(p.ws + WS_POOLED);
    const bf16_t* PWT = (const bf16_t*)(p.ws + WS_PW);
    bf16_t* YB = (bf16_t*)(p.ws + WS_YB);
    const int fr = lane & 15, fq = lane >> 4;
    for (int item = gw; item < (MT / 16) * 4; item += NGW) {
        const int rb = item >> 2, gi = item & 3;
        const int row = rb * 16 + fr;
        bf16x8 af[4];
#pragma unroll
        for (int ks = 0; ks < 4; ++ks) af[ks] = *(const bf16x8*)(POOLED + (size_t)row * DPL + gi * 128 + ks * 32 + fq * 8);
#pragma unroll 2
        for (int nb = 0; nb < 8; ++nb) {
            f32x4 acc = (f32x4){0.f, 0.f, 0.f, 0.f};
#pragma unroll
            for (int ks = 0; ks < 4; ++ks) {
                const bf16x8 bfrag = *(const bf16x8*)(PWT + (size_t)gi * 16384 + (nb * 16 + fr) * 128 + ks * 32 + fq * 8);
                acc = __builtin_amdgcn_mfma_f32_16x16x32_bf16(bfrag, af[ks], acc, 0, 0, 0);
            }
            const int col = gi * 128 + nb * 16 + fq * 4;
            const f32x4 sc = *(const f32x4*)(p.pool_scale + col);
            const u32x2 zw = *(const u32x2*)(PROJ + (size_t)row * DIN + 2560 + col);
            const float y0 = acc[0] * sc[0] * silu(bf_lo(zw.x)), y1 = acc[1] * sc[1] * silu(bf_hi(zw.x));
            const float y2 = acc[2] * sc[2] * silu(bf_lo(zw.y)), y3 = acc[3] * sc[3] * silu(bf_hi(zw.y));
            u32x2 o; o.x = cvt_pk_bf16(y0, y1); o.y = cvt_pk_bf16(y2, y3);
            *(u32x2*)(YB + (size_t)row * DM + 512 + col) = o;
        }
    }
}

__device__ __forceinline__ void phase_final(const Params& p, int gw, int NGW, int lane) {
    f32x4 g[4];
#pragma unroll
    for (int j = 0; j < 4; ++j) g[j] = *((const f32x4*)p.final_g + lane + 64 * j);
    for (int r = gw; r < MT; r += NGW) {
        f32x4* row = (f32x4*)(p.out + (size_t)r * DM) + lane;
        f32x4 v[4]; float s = 0.f;
#pragma unroll
        for (int j = 0; j < 4; ++j) { v[j] = row[64 * j]; s += (v[j].x * v[j].x + v[j].y * v[j].y) + (v[j].z * v[j].z + v[j].w * v[j].w); }
        const float rinv = rsqrtf(wave_sum(s) * (1.0f / DM) + EPS);
#pragma unroll
        for (int j = 0; j < 4; ++j) row[64 * j] = v[j] * rinv * g[j];
    }
}

__global__ void __launch_bounds__(512, 2) fwd_megakernel(Params p) {
    extern __shared__ __attribute__((aligned(16))) unsigned char shm[];
    LAS unsigned char* lds = (LAS unsigned char*)shm;
    cg::grid_group grid = cg::this_grid();
    if (p.never) grid.sync();
    volatile LAS unsigned* xst = (volatile LAS unsigned*)(lds + STAGE_BYTES);
    if (threadIdx.x == 0) { xst[0] = 0u; xst[1] = 0u; }
    __syncthreads();
    const XcdBarrier xb = xcd_barrier_post((unsigned*)(p.ws + WS_BAR), xst);
    const int tid = threadIdx.x, wave = tid >> 6, lane = tid & 63;
    const int gw = blockIdx.x * 8 + wave, NGW = gridDim.x * 8;

    phase_prep(p, lds, gw, NGW, wave, lane);
    xcd_barrier(xb);
    { Gemm g{(const bf16_t*)(p.ws + WS_XN), (const bf16_t*)(p.ws + WS_WIN), MT, DIN, DM};
      StaticOrder S; S.init(MT, DIN, (int)gridDim.x, (int)blockIdx.x);
      EpiProj E{(bf16_t*)(p.ws + WS_PROJ)};
      gemm_phase(lds, g, S, E); }
    xcd_barrier(xb);
    phase_mix(p, gw, NGW, lane);
    xcd_barrier(xb);
    phase_poolgemm(p, gw, NGW, lane);
    xcd_barrier(xb);
    { Gemm g{(const bf16_t*)(p.ws + WS_YB), (const bf16_t*)(p.ws + WS_WOUT), MT, DM, DM};
      StaticOrder S; S.init(MT, DM, (int)gridDim.x, (int)blockIdx.x);
      EpiOut E{p.out, p.xp, p.xs};
      gemm_phase(lds, g, S, E); }
    xcd_barrier(xb);
    phase_final(p, gw, NGW, lane);
}

extern "C" void kernel_launch(void* const* d_in, const int* in_sizes, int n_in, void* d_out, int out_size, void* d_ws, size_t ws_size, hipStream_t stream) {
    static int grid_blocks = 0;
    if (!grid_blocks) {
        int dev = 0, cus = 0, per_cu = 0;
        (void)hipGetDevice(&dev);
        (void)hipDeviceGetAttribute(&cus, hipDeviceAttributeMultiprocessorCount, dev);
        if (hipFuncSetAttribute((const void*)fwd_megakernel, hipFuncAttributeMaxDynamicSharedMemorySize, LDS_BYTES) != hipSuccess) fprintf(stderr, "hipFuncSetAttribute failed\n");
        (void)hipOccupancyMaxActiveBlocksPerMultiprocessor(&per_cu, (const void*)fwd_megakernel, 512, LDS_BYTES);
        if (per_cu < 1) { fprintf(stderr, "occupancy query says %d blocks/CU\n", per_cu); per_cu = 1; }
        grid_blocks = cus * per_cu;
        (void)hipGetLastError();
    }
    (void)hipMemsetAsync((char*)d_ws + WS_BAR, 0, XCD_BAR_WORDS * 4, stream);
    Params p{};
    p.xp = (const float*)d_in[0]; p.xs = (const float*)d_in[1]; p.sconv = (const float*)d_in[2]; p.spool = (const float*)d_in[3];
    p.norm_g = (const float*)d_in[4]; p.w_in = (const float*)d_in[5]; p.conv_w = (const float*)d_in[6]; p.pool_w = (const float*)d_in[7];
    p.pool_scale = (const float*)d_in[8]; p.w_out = (const float*)d_in[9]; p.final_g = (const float*)d_in[10];
    p.out = (float*)d_out; p.ws = (unsigned char*)d_ws;
    void* args[] = {&p};
    hipError_t e = hipLaunchCooperativeKernel((void*)fwd_megakernel, dim3(grid_blocks), dim3(512), args, LDS_BYTES, stream);
    if (e != hipSuccess) fprintf(stderr, "cooperative launch failed: %s (grid %d)\n", hipGetErrorString(e), grid_blocks);
}
```

```cpp
#include <hip/hip_runtime.h>
#include <hip/hip_cooperative_groups.h>
#include <cstdio>
namespace cg = cooperative_groups;

#define LAS __attribute__((address_space(3)))
typedef unsigned short bf16_t;
typedef short bf16x8 __attribute__((ext_vector_type(8)));
typedef float f32x4 __attribute__((ext_vector_type(4)));
typedef unsigned u32x4 __attribute__((ext_vector_type(4)));
typedef unsigned u32x2 __attribute__((ext_vector_type(2)));

constexpr int MP = 16384, MS = 512, MT = MP + MS, DM = 1024, DIN = 3072, DC = 512, DPL = 512;
constexpr int SEQ = 2048, DSEQ = 4;
constexpr float EPS = 1e-6f;
constexpr int BM = 256, BK = 64, HALF = 128, HTB = HALF * BK * 2, STAGE_BYTES = 8 * HTB, NXCD = 8, WGM = 8;
constexpr int LDS_BYTES = STAGE_BYTES + 16;

constexpr size_t WS_BAR = 0;
constexpr size_t WS_XN = 16384;
constexpr size_t WS_WIN = WS_XN + (size_t)MT * DM * 2;
constexpr size_t WS_WOUT = WS_WIN + (size_t)DIN * DM * 2;
constexpr size_t WS_PW = WS_WOUT + (size_t)DM * DM * 2;
constexpr size_t WS_P2 = WS_PW + (size_t)4 * 128 * 128 * 2;
constexpr size_t WS_YB = WS_P2 + (size_t)MT * 2048 * 2;
constexpr size_t WS_END = WS_YB + (size_t)MT * DM * 2;
constexpr int P2LD = 2048;

constexpr size_t O_Y = 0;
constexpr size_t O_CONVP = (size_t)MT * DM;
constexpr size_t O_POOLP = O_CONVP + 8 * 2 * 512;
constexpr size_t O_CONVS = O_POOLP + 8 * 15 * 512;
constexpr size_t O_POOLS = O_CONVS + 128 * 2 * 512;

struct Params {
    const float *xp, *xs, *sconv, *spool, *norm_g, *w_in, *conv_w, *pool_w, *pool_scale, *w_out, *final_g;
    float* out;
    unsigned char* ws;
    unsigned long long never;
};

__device__ __forceinline__ unsigned cvt_pk_bf16(float lo, float hi) { unsigned r; asm volatile("v_cvt_pk_bf16_f32 %0, %1, %2" : "=v"(r) : "v"(lo), "v"(hi)); return r; }
__device__ __forceinline__ float bf_lo(unsigned w) { return __uint_as_float(w << 16); }
__device__ __forceinline__ float bf_hi(unsigned w) { return __uint_as_float(w & 0xffff0000u); }
__device__ __forceinline__ float wave_sum(float v) {
#pragma unroll
    for (int o = 1; o < 64; o <<= 1) v += __shfl_xor(v, o);
    return v;
}
__device__ __forceinline__ float silu(float z) { return z / (1.0f + __expf(-z)); }

struct F8 { float v[8]; };
__device__ __forceinline__ F8 ld_bf8(const bf16_t* p) {
    const u32x4 w = *(const u32x4*)p; F8 r;
    r.v[0] = bf_lo(w.x); r.v[1] = bf_hi(w.x); r.v[2] = bf_lo(w.y); r.v[3] = bf_hi(w.y);
    r.v[4] = bf_lo(w.z); r.v[5] = bf_hi(w.z); r.v[6] = bf_lo(w.w); r.v[7] = bf_hi(w.w); return r;
}
__device__ __forceinline__ F8 ld_f8(const float* p) {
    const f32x4 a = *(const f32x4*)p, b = *(const f32x4*)(p + 4); F8 r;
    r.v[0] = a.x; r.v[1] = a.y; r.v[2] = a.z; r.v[3] = a.w; r.v[4] = b.x; r.v[5] = b.y; r.v[6] = b.z; r.v[7] = b.w; return r;
}
__device__ __forceinline__ void st_f8(float* p, const F8& r) {
    *(f32x4*)p = (f32x4){r.v[0], r.v[1], r.v[2], r.v[3]}; *(f32x4*)(p + 4) = (f32x4){r.v[4], r.v[5], r.v[6], r.v[7]};
}
__device__ __forceinline__ void st_bf8(bf16_t* p, const F8& r) {
    u32x4 w; w.x = cvt_pk_bf16(r.v[0], r.v[1]); w.y = cvt_pk_bf16(r.v[2], r.v[3]); w.z = cvt_pk_bf16(r.v[4], r.v[5]); w.w = cvt_pk_bf16(r.v[6], r.v[7]);
    *(u32x4*)p = w;
}


#define XB_TMO      128
#define XB_XCNT(j)  (256  + 64 * (j))
#define XB_XSUB(j)  (1280 + 64 * (j))
#define XB_XGEN(j)  (2304 + 64 * (j))
#define XB_TOP      3328
#define XB_TOPGEN   3392
#define XCD_BAR_WORDS 3456
#define XB_SPIN_CAP (1u << 18)
__device__ __forceinline__ unsigned xb_ld(unsigned* p)              { return __hip_atomic_load(p, __ATOMIC_RELAXED, __HIP_MEMORY_SCOPE_AGENT); }
__device__ __forceinline__ unsigned xb_add(unsigned* p, unsigned v) { return __hip_atomic_fetch_add(p, v, __ATOMIC_RELAXED, __HIP_MEMORY_SCOPE_AGENT); }
__device__ __forceinline__ unsigned xb_xcc_id() { return (unsigned)__builtin_amdgcn_s_getreg((3 << 11) | 20) & 0xFu; }
#define XB_SPIN(cond, bar) do { unsigned _sp = 0; while (cond) { __builtin_amdgcn_s_sleep(1); \
    if ((++_sp & 255u) == 0u) { if (xb_ld(&(bar)[XB_TMO])) break; if (_sp > XB_SPIN_CAP) { atomicAdd(&(bar)[XB_TMO], 1u); break; } } } } while (0)
struct XcdBarrier { unsigned* bar; unsigned x; volatile LAS unsigned* st; };
__device__ __forceinline__ XcdBarrier xcd_barrier_post(unsigned* bar, volatile LAS unsigned* st) {
    XcdBarrier b; b.bar = bar; b.x = xb_xcc_id(); b.st = st;
    if (threadIdx.x == 0) (void)xb_add(&bar[XB_XCNT(b.x)], 1u);
    return b;
}
__device__ __forceinline__ void xcd_barrier_complete(unsigned* bar, unsigned x, unsigned& nloc, unsigned& nx) {
    const unsigned G = gridDim.x * gridDim.y * gridDim.z;
    unsigned sum, cnt, mine, sp = 0u;
    for (;;) {
        sum = 0u; cnt = 0u; mine = 0u;
#pragma unroll
        for (unsigned j = 0; j < 16; ++j) { const unsigned c = xb_ld(&bar[XB_XCNT(j)]); sum += c; cnt += (c > 0u) ? 1u : 0u; mine = (j == x) ? c : mine; }
        if (sum == G) break;
        __builtin_amdgcn_s_sleep(1);
        if ((++sp & 255u) == 0u) { if (xb_ld(&bar[XB_TMO])) break; if (sp > XB_SPIN_CAP) { atomicAdd(&bar[XB_TMO], 1u); break; } }
    }
    nloc = mine > 0u ? mine : 1u; nx = cnt > 0u ? cnt : 1u;
}
__device__ __forceinline__ void xcd_barrier(const XcdBarrier& b) {
    asm volatile("s_waitcnt vmcnt(0)" ::: "memory");
    __syncthreads();
    if (threadIdx.x == 0) {
        unsigned* bar = b.bar;
        unsigned bx = b.x;
        asm volatile("" : "+s"(bar), "+s"(bx));
        __builtin_amdgcn_s_waitcnt(0);
        unsigned nloc = b.st[0], nx = b.st[1];
        if (nloc == 0u) { xcd_barrier_complete(bar, bx, nloc, nx); b.st[0] = nloc; b.st[1] = nx; }
        const unsigned old = xb_add(&bar[XB_XSUB(bx)], 1u);
        const unsigned gen = old / nloc;
        if (old + 1u == (gen + 1u) * nloc) {
            __builtin_amdgcn_fence(__ATOMIC_RELEASE, "agent");
            asm volatile("s_waitcnt vmcnt(0)" ::: "memory");
            const unsigned og = xb_add(&bar[XB_TOP], 1u);
            const unsigned tg = og / nx;
            if (og + 1u == (tg + 1u) * nx) xb_add(&bar[XB_TOPGEN], 1u);
            else XB_SPIN(xb_ld(&bar[XB_TOPGEN]) == tg, bar);
            __builtin_amdgcn_fence(__ATOMIC_ACQUIRE, "agent");
            xb_add(&bar[XB_XGEN(bx)], 1u);
            asm volatile("s_waitcnt vmcnt(0)" ::: "memory");
        } else {
            XB_SPIN(xb_ld(&bar[XB_XGEN(bx)]) == gen, bar);
            __builtin_amdgcn_fence(__ATOMIC_ACQUIRE, "agent");
            asm volatile("s_waitcnt vmcnt(0)" ::: "memory");
        }
    }
    __syncthreads();
}

__host__ __device__ __forceinline__ int lds_byte(int r, int c) { const int st = (r >> 4) * 2 + (c >> 5), rr = r & 15, cc = c & 31, ob = rr * 64 + cc * 2; return st * 1024 + (ob ^ (((ob >> 9) & 1) << 5)); }
__host__ __device__ __forceinline__ void stage_rc(int b, int& R, int& C) { const int st = b / 1024, sb = b % 1024, swz = sb ^ (((sb >> 9) & 1) << 5); R = (st >> 1) * 16 + swz / 64; C = (st & 1) * 32 + (swz % 64) / 2; }
__host__ __device__ __forceinline__ int perm32(int rho) { const int n = rho >> 4, i = rho & 15; return 8 * (i >> 2) + 4 * n + (i & 3); }

struct Unit { int pm, pn; };
struct Gemm { const bf16_t* A; const bf16_t* Bt; int M, N, K; };

struct Order {
    int nM, nN, nwg, G, c, pm0;
    __device__ void init(int nM_, int nN_, int pm0_, int G_, int c_) { nM = nM_; nN = nN_; nwg = nM * nN; G = G_; c = c_; pm0 = pm0_; }
    __device__ bool next(int i, Unit& u) const {
        const long L = (long)i * G + c; if (L >= nwg) return false;
        int wgid = (int)L; { const int q = nwg / NXCD, r = nwg % NXCD, xcd = wgid % NXCD, off = wgid / NXCD; wgid = (xcd < r ? xcd * (q + 1) : r * (q + 1) + (xcd - r) * q) + off; }
        const int nig = WGM * nN, gid = wgid / nig, fm = gid * WGM, gsz = (nM - fm) < WGM ? (nM - fm) : WGM;
        u.pm = pm0 + fm + ((wgid % nig) % gsz); u.pn = (wgid % nig) / gsz; return true;
    }
};

struct EpiMix {
    static constexpr bool PERM = true;
    bf16_t* P2; float* out;
    __device__ __forceinline__ void operator()(const f32x4 (&acc)[2][2][4][2], const Unit& u, int wr, int wc, int fr, int fq) const {
        const int ty = u.pn >> 2, loc = (u.pn & 3) * 128 + wc * 32 + 8 * fq;
        const int rowt = u.pm * BM + wr * 64 + fr;
#pragma unroll
        for (int ai = 0; ai < 2; ++ai)
#pragma unroll
            for (int m = 0; m < 4; ++m) {
                const int row = rowt + ai * HALF + m * 16;
                bf16_t* prow = P2 + (size_t)row * P2LD + loc;
                F8 a, b;
#pragma unroll
                for (int i = 0; i < 4; ++i) { a.v[i] = acc[ai][0][m][0][i]; a.v[4 + i] = acc[ai][0][m][1][i]; b.v[i] = acc[ai][1][m][0][i]; b.v[4 + i] = acc[ai][1][m][1][i]; }
                int sb, st; bool samp = row >= MP;
                if (!samp) { sb = row >> 11; st = row & (SEQ - 1); } else { const int q = row - MP; sb = q >> 2; st = q & 3; }
                if (ty == 0) {
                    F8 cu;
#pragma unroll
                    for (int i = 0; i < 8; ++i) cu.v[i] = a.v[i] * b.v[i];
                    st_bf8(prow, cu);
                    if (!samp) { if (st >= SEQ - 2) st_f8(out + O_CONVP + ((size_t)sb * 2 + (st - (SEQ - 2))) * DC + loc, cu); }
                    else if (st >= 2) st_f8(out + O_CONVS + ((size_t)sb * 2 + (st - 2)) * DC + loc, cu);
                } else if (ty == 1) {
                    F8 bs;
#pragma unroll
                    for (int i = 0; i < 8; ++i) bs.v[i] = a.v[i] * silu(b.v[i]);
                    st_bf8(prow + 512, bs);
                } else {
                    F8 zs;
#pragma unroll
                    for (int i = 0; i < 8; ++i) zs.v[i] = silu(b.v[i]);
                    st_bf8(prow + 1024, a); st_bf8(prow + 1536, zs);
                    if (!samp) { if (st >= SEQ - 15) st_f8(out + O_POOLP + ((size_t)sb * 15 + (st - (SEQ - 15))) * DPL + loc, a); }
                    else st_f8(out + O_POOLS + ((size_t)sb * 15 + 11 + st) * DPL + loc, a);
                }
            }
    }
};
struct EpiOut {
    static constexpr bool PERM = false;
    float* out; const float* xp; const float* xs;
    __device__ __forceinline__ void operator()(const f32x4 (&acc)[2][2][4][2], const Unit& u, int wr, int wc, int fr, int fq) const {
        const int row0 = u.pm * BM + wr * 64 + fr, col0 = u.pn * BM + wc * 32 + 4 * fq;
        const float* xbase = (u.pm * BM < MP) ? xp : (xs - (size_t)MP * DM);
#pragma unroll
        for (int ai = 0; ai < 2; ++ai)
#pragma unroll
            for (int m = 0; m < 4; ++m) { const size_t ro = (size_t)(row0 + ai * HALF + m * 16) * DM + col0; float* rowp = out + ro; const float* xr = xbase + ro;
#pragma unroll
                for (int bj = 0; bj < 2; ++bj)
#pragma unroll
                    for (int n = 0; n < 2; ++n) *(f32x4*)(rowp + bj * HALF + n * 16) = acc[ai][bj][m][n] + *(const f32x4*)(xr + bj * HALF + n * 16); }
    }
};

template <class Epi, class Sched>
__device__ __forceinline__ void gemm_phase(LAS unsigned char* lds, const Gemm g, const Sched& S, const Epi& E) {
    const int tid = threadIdx.x, wid = __builtin_amdgcn_readfirstlane(tid >> 6), lane = tid & 63, wr = wid >> 2, wc = wid & 3, fr = lane & 15, fq = lane >> 4;
    const int K = g.K, nt = K / BK;
    unsigned voffA[2], voffB[2];
#pragma unroll
    for (int i = 0; i < 2; ++i) { int R, C; stage_rc(tid * 16 + i * 8192, R, C); const int Rb = Epi::PERM ? ((R & ~31) + perm32(R & 31)) : R;
        voffA[i] = (unsigned)(R * K + C) * 2u; voffB[i] = (unsigned)(Rb * K + C) * 2u; }
    const size_t kstep = (size_t)(BK * 2);
    const size_t hstep = (size_t)HALF * K * 2;
    const size_t tstep = 2 * hstep;
    const unsigned ldsw = (unsigned)wid * 1024u;
    const int aoff = lds_byte(wr * 64 + fr, fq * 8), boff = lds_byte(wc * 32 + fr, fq * 8);
#define PG8_SA(b, h) (((b) * 2 + (h)) * HTB)
#define PG8_SB(b, h) ((4 + (b) * 2 + (h)) * HTB)
#define PG8_STAGE(bufoff, gbase, voff) do { _Pragma("unroll") for (int _i = 0; _i < 2; ++_i) \
        __builtin_amdgcn_global_load_lds((const unsigned*)((const char*)(gbase) + (voff)[_i]), (LAS unsigned*)(lds + (bufoff) + ldsw + _i * 8192), 16, 0, 0); } while (0)
#define PG8_LDA(dst, b, h) do { _Pragma("unroll") for (int m = 0; m < 4; ++m) _Pragma("unroll") for (int k = 0; k < 2; ++k) dst[m][k] = *(const LAS bf16x8*)(lds + PG8_SA(b, h) + aoff + m * 2048 + k * 1024); } while (0)
#define PG8_LDB(dst, b, h) do { _Pragma("unroll") for (int n = 0; n < 2; ++n) _Pragma("unroll") for (int k = 0; k < 2; ++k) dst[n][k] = *(const LAS bf16x8*)(lds + PG8_SB(b, h) + boff + n * 2048 + k * 1024); } while (0)
#define PG8_MMA(ai, bj, At, Bt) do { __builtin_amdgcn_s_setprio(1); _Pragma("unroll") for (int m = 0; m < 4; ++m) _Pragma("unroll") for (int n = 0; n < 2; ++n) _Pragma("unroll") for (int k = 0; k < 2; ++k) \
        acc[ai][bj][m][n] = __builtin_amdgcn_mfma_f32_16x16x32_bf16(Bt[n][k], At[m][k], acc[ai][bj][m][n], 0, 0, 0); __builtin_amdgcn_s_setprio(0); } while (0)
#define PG8_WAIT_V(n) asm volatile("s_waitcnt vmcnt(" #n ")" ::: "memory")
#define PG8_WAIT_L(n) asm volatile("s_waitcnt lgkmcnt(" #n ")" ::: "memory")
#define PG8_BAR __builtin_amdgcn_s_barrier()
#define PG8_SCHED __builtin_amdgcn_sched_barrier(0)
    Unit cur, nxt; int ui = 0;
    if (!S.next(0, cur)) return;
    f32x4 acc[2][2][4][2];
#pragma unroll
    for (int a = 0; a < 2; ++a)
#pragma unroll
        for (int b = 0; b < 2; ++b)
#pragma unroll
            for (int m = 0; m < 4; ++m)
#pragma unroll
                for (int n = 0; n < 2; ++n) acc[a][b][m][n] = (f32x4){0.f, 0.f, 0.f, 0.f};
    bf16x8 At[4][2], B0[2][2], B1[2][2];
    const char* cA = (const char*)g.A + (size_t)cur.pm * tstep; const char* cB = (const char*)g.Bt + (size_t)cur.pn * tstep;
    PG8_STAGE(PG8_SB(0, 0), cB, voffB); PG8_STAGE(PG8_SA(0, 0), cA, voffA); PG8_STAGE(PG8_SB(0, 1), cB + hstep, voffB); PG8_STAGE(PG8_SA(0, 1), cA + hstep, voffA);
    if (wr == 1) PG8_BAR;
    PG8_WAIT_V(4); PG8_BAR;
    PG8_STAGE(PG8_SB(1, 0), cB + kstep, voffB); PG8_STAGE(PG8_SA(1, 0), cA + kstep, voffA); PG8_STAGE(PG8_SB(1, 1), cB + hstep + kstep, voffB);
    PG8_WAIT_V(6); PG8_BAR;
    for (;;) {
        const bool has_next = S.next(ui + 1, nxt);
        const char* nA = has_next ? (const char*)g.A + (size_t)nxt.pm * tstep : cA; const char* nB = has_next ? (const char*)g.Bt + (size_t)nxt.pn * tstep : cB;
        for (int t = 0; t < nt; t += 2) {
            const bool last = (t == nt - 2);
            const char* a1 = cA + (size_t)(t + 1) * kstep;
            const char* a2 = last ? nA : cA + (size_t)(t + 2) * kstep; const char* b2 = last ? nB : cB + (size_t)(t + 2) * kstep;
            const char* a3 = a2 + kstep; const char* b3 = b2 + kstep;
            PG8_LDB(B0, 0, 0); PG8_SCHED; PG8_LDA(At, 0, 0); PG8_STAGE(PG8_SA(1, 1), a1 + hstep, voffA);
            PG8_WAIT_L(8); PG8_BAR; PG8_WAIT_L(0); PG8_MMA(0, 0, At, B0); PG8_BAR; PG8_SCHED;
            PG8_LDB(B1, 0, 1); PG8_STAGE(PG8_SB(0, 0), b2, voffB);
            PG8_BAR; PG8_WAIT_L(0); PG8_MMA(0, 1, At, B1); PG8_BAR;
            PG8_LDA(At, 0, 1); PG8_STAGE(PG8_SA(0, 0), a2, voffA);
            PG8_BAR; PG8_WAIT_L(0); PG8_MMA(1, 0, At, B0); PG8_BAR; PG8_SCHED;
            PG8_STAGE(PG8_SB(0, 1), b2 + hstep, voffB);
            PG8_WAIT_V(6); PG8_BAR; PG8_MMA(1, 1, At, B1); PG8_BAR;
            PG8_LDB(B0, 1, 0); PG8_SCHED; PG8_LDA(At, 1, 0); PG8_STAGE(PG8_SA(0, 1), a2 + hstep, voffA);
            PG8_WAIT_L(8); PG8_BAR; PG8_WAIT_L(0); PG8_MMA(0, 0, At, B0); PG8_BAR; PG8_SCHED;
            PG8_LDB(B1, 1, 1); PG8_STAGE(PG8_SB(1, 0), b3, voffB);
            PG8_BAR; PG8_WAIT_L(0); PG8_MMA(0, 1, At, B1); PG8_BAR;
            PG8_LDA(At, 1, 1); PG8_STAGE(PG8_SA(1, 0), a3, voffA);
            PG8_BAR; PG8_WAIT_L(0); PG8_MMA(1, 0, At, B0); PG8_BAR; PG8_SCHED;
            PG8_STAGE(PG8_SB(1, 1), b3 + hstep, voffB);
            PG8_WAIT_V(6); PG8_BAR; PG8_MMA(1, 1, At, B1); PG8_BAR;
        }
        E(acc, cur, wr, wc, fr, fq);
        if (!has_next) break;
#pragma unroll
        for (int a = 0; a < 2; ++a)
#pragma unroll
            for (int b = 0; b < 2; ++b)
#pragma unroll
                for (int m = 0; m < 4; ++m)
#pragma unroll
                    for (int n = 0; n < 2; ++n) acc[a][b][m][n] = (f32x4){0.f, 0.f, 0.f, 0.f};
        cur = nxt; cA = nA; cB = nB; ++ui;
    }
    PG8_WAIT_V(0);
    if (wr == 0) PG8_BAR;
    PG8_BAR;
#undef PG8_SA
#undef PG8_SB
#undef PG8_STAGE
#undef PG8_LDA
#undef PG8_LDB
#undef PG8_MMA
#undef PG8_WAIT_V
#undef PG8_WAIT_L
#undef PG8_BAR
#undef PG8_SCHED
}

__device__ __forceinline__ void p0_transpose_item(const float* W, int K, int N, bf16_t* WT, LAS float* scr, int k0, int nsrc0, int ndst0, int lane) {
#pragma unroll 8
    for (int i = 0; i < 32; ++i) { const int kk = 2 * i + (lane >> 5); scr[kk * 33 + (lane & 31)] = W[(size_t)(k0 + kk) * N + nsrc0 + (lane & 31)]; }
    asm volatile("s_waitcnt lgkmcnt(0)" ::: "memory");
    const int c = lane & 7;
#pragma unroll
    for (int j = 0; j < 4; ++j) { const int n = (lane >> 3) + 8 * j; const LAS float* s = scr + (8 * c) * 33 + n;
        u32x4 o; o.x = cvt_pk_bf16(s[0 * 33], s[1 * 33]); o.y = cvt_pk_bf16(s[2 * 33], s[3 * 33]); o.z = cvt_pk_bf16(s[4 * 33], s[5 * 33]); o.w = cvt_pk_bf16(s[6 * 33], s[7 * 33]);
        *(u32x4*)(WT + (size_t)(ndst0 + n) * K + k0 + 8 * c) = o; }
    asm volatile("s_waitcnt lgkmcnt(0)" ::: "memory");
}
__device__ __forceinline__ int win_src_col(int np) {
    const int pn = np >> 8, half = (np >> 7) & 1, ty = pn >> 2, ch = (pn & 3) * 128 + (np & 127);
    return ty == 0 ? (half ? 1024 + ch : 512 + ch) : ty == 1 ? (half ? 1536 + ch : ch) : (half ? 2560 + ch : 2048 + ch);
}

__device__ __forceinline__ void phase_prep(const Params& p, LAS unsigned char* lds, int gw, int NGW, int wave, int lane) {
    asm volatile("" : "+v"(lane), "+s"(gw), "+s"(wave));
    bf16_t* XN = (bf16_t*)(p.ws + WS_XN);
    LAS float* scr = (LAS float*)(lds + wave * 16384);
    constexpr int I_IN = (DM / 64) * (DIN / 32), I_OUT = (DM / 64) * (DM / 32), I_PW = 4 * (128 / 64) * (128 / 32);
    for (int it = gw; it < I_IN + I_OUT + I_PW; it += NGW) {
        int r = it;
        if (r < I_IN) { const int kb = r / (DIN / 32), nb = r % (DIN / 32); p0_transpose_item(p.w_in, DM, DIN, (bf16_t*)(p.ws + WS_WIN), scr, 64 * kb, win_src_col(32 * nb), 32 * nb, lane); continue; } r -= I_IN;
        if (r < I_OUT) { const int kb = r / (DM / 32), nb = r % (DM / 32); p0_transpose_item(p.w_out, DM, DM, (bf16_t*)(p.ws + WS_WOUT), scr, 64 * kb, 32 * nb, 32 * nb, lane); continue; } r -= I_OUT;
        const int gidx = r >> 3, q = r & 7; p0_transpose_item(p.pool_w + gidx * 16384, 128, 128, (bf16_t*)(p.ws + WS_PW) + gidx * 16384, scr, 64 * (q >> 2), 32 * (q & 3), 32 * (q & 3), lane);
    }
    f32x4 g[4];
#pragma unroll
    for (int j = 0; j < 4; ++j) g[j] = *((const f32x4*)p.norm_g + lane + 64 * j);
    for (int r = gw; r < MT; r += 2 * NGW) {
        const int r2 = r + NGW; const bool has2 = r2 < MT; const int rb = has2 ? r2 : r;
        const float* xa = (r < MP) ? p.xp + (size_t)r * DM : p.xs + (size_t)(r - MP) * DM;
        const float* xb = (rb < MP) ? p.xp + (size_t)rb * DM : p.xs + (size_t)(rb - MP) * DM;
        f32x4 va[4], vb[4]; float sa = 0.f, sb = 0.f;
#pragma unroll
        for (int j = 0; j < 4; ++j) { va[j] = *((const f32x4*)xa + lane + 64 * j); vb[j] = *((const f32x4*)xb + lane + 64 * j); }
#pragma unroll
        for (int j = 0; j < 4; ++j) { sa += (va[j].x * va[j].x + va[j].y * va[j].y) + (va[j].z * va[j].z + va[j].w * va[j].w); sb += (vb[j].x * vb[j].x + vb[j].y * vb[j].y) + (vb[j].z * vb[j].z + vb[j].w * vb[j].w); }
        const float ra = rsqrtf(wave_sum(sa) * (1.0f / DM) + EPS), rbv = rsqrtf(wave_sum(sb) * (1.0f / DM) + EPS);
        u32x2* oa = (u32x2*)(XN + (size_t)r * DM) + lane; u32x2* ob = (u32x2*)(XN + (size_t)rb * DM) + lane;
#pragma unroll
        for (int j = 0; j < 4; ++j) { u32x2 w; w.x = cvt_pk_bf16(va[j].x * ra * g[j].x, va[j].y * ra * g[j].y); w.y = cvt_pk_bf16(va[j].z * ra * g[j].z, va[j].w * ra * g[j].w); oa[64 * j] = w; }
        if (has2) {
#pragma unroll
            for (int j = 0; j < 4; ++j) { u32x2 w; w.x = cvt_pk_bf16(vb[j].x * rbv * g[j].x, vb[j].y * rbv * g[j].y); w.y = cvt_pk_bf16(vb[j].z * rbv * g[j].z, vb[j].w * rbv * g[j].w); ob[64 * j] = w; } }
    }
    for (int i = gw * 64 + lane; i < 128 * 11 * 128; i += NGW * 64) {
        const int b = i / (11 * 128), rem = i - b * (11 * 128);
        *((f32x4*)(p.out + O_POOLS + (size_t)b * 15 * DPL) + rem) = *((const f32x4*)(p.spool + ((size_t)b * 15 + 4) * DPL) + rem);
    }
}

__device__ __forceinline__ F8 unpack8(const u32x4 w) { F8 r;
    r.v[0] = bf_lo(w.x); r.v[1] = bf_hi(w.x); r.v[2] = bf_lo(w.y); r.v[3] = bf_hi(w.y); r.v[4] = bf_lo(w.z); r.v[5] = bf_hi(w.z); r.v[6] = bf_lo(w.w); r.v[7] = bf_hi(w.w); return r; }

struct ConvW { F8 w0, w1, w2; };
__device__ __forceinline__ ConvW load_convw(const Params& p, int c0) { ConvW c; c.w0 = ld_f8(p.conv_w + c0); c.w1 = ld_f8(p.conv_w + DC + c0); c.w2 = ld_f8(p.conv_w + 2 * DC + c0); return c; }

__device__ __forceinline__ void conv_item_prompt(const bf16_t* P2, bf16_t* YB, const ConvW& cw, int r0, int c0) {
    const bf16_t* base = P2 + (size_t)r0 * P2LD + c0;
    u32x4 cuw[10], bsw[8];
    const u32x4 z4 = (u32x4){0u, 0u, 0u, 0u};
    if ((r0 & (SEQ - 1)) != 0) { cuw[0] = *(const u32x4*)(base - 2 * P2LD); cuw[1] = *(const u32x4*)(base - P2LD); } else { cuw[0] = z4; cuw[1] = z4; }
#pragma unroll
    for (int i = 0; i < 8; ++i) { cuw[2 + i] = *(const u32x4*)(base + i * P2LD); bsw[i] = *(const u32x4*)(base + i * P2LD + 512); }
    F8 c2 = unpack8(cuw[0]), c1 = unpack8(cuw[1]);
#pragma unroll
    for (int i = 0; i < 8; ++i) {
        const F8 c0v = unpack8(cuw[2 + i]), bs = unpack8(bsw[i]); F8 y;
#pragma unroll
        for (int e = 0; e < 8; ++e) y.v[e] = bs.v[e] * (cw.w0.v[e] * c2.v[e] + cw.w1.v[e] * c1.v[e] + cw.w2.v[e] * c0v.v[e]);
        st_bf8(YB + (size_t)(r0 + i) * DM + c0, y);
        c2 = c1; c1 = c0v;
    }
}
__device__ __forceinline__ void conv_item_sample(const Params& p, const bf16_t* P2, bf16_t* YB, const ConvW& cw, int row, int c0) {
    const int q = row - MP, b = q >> 2, t = q & 3;
    const bf16_t* base = P2 + (size_t)row * P2LD + c0;
    const F8 c0v = ld_bf8(base), bs = ld_bf8(base + 512);
    F8 c1, c2;
    if (t >= 1) c1 = ld_bf8(base - P2LD); else c1 = ld_f8(p.sconv + ((size_t)b * 2 + 1) * DC + c0);
    if (t >= 2) c2 = ld_bf8(base - 2 * P2LD); else c2 = ld_f8(p.sconv + ((size_t)b * 2 + t) * DC + c0);
    F8 y;
#pragma unroll
    for (int e = 0; e < 8; ++e) y.v[e] = bs.v[e] * (cw.w0.v[e] * c2.v[e] + cw.w1.v[e] * c1.v[e] + cw.w2.v[e] * c0v.v[e]);
    st_bf8(YB + (size_t)row * DM + c0, y);
}
template <bool SAMP>
__device__ __forceinline__ void pool_item(const Params& p, const bf16_t* P2, const bf16_t* PWT, bf16_t* YB, int rb, int gi, int lane) {
    const int fr = lane & 15, fq = lane >> 4;
    const int row = rb * 16 + fr, w = 2 << gi;
    int t, b = 0;
    if (!SAMP) t = row & (SEQ - 1); else { const int q = row - MP; b = q >> 2; t = q & 3; }
    const bf16_t* vp = P2 + (size_t)row * P2LD + 1024 + gi * 128 + fq * 8;
    F8 v0[4], sum[4];
#pragma unroll
    for (int ks = 0; ks < 4; ++ks) { v0[ks] = ld_bf8(vp + ks * 32); sum[ks] = v0[ks]; }
#pragma unroll 2
    for (int j = 1; j < w; ++j) {
        const int tt = t - j;
        if (!SAMP) {
            const bool ok = tt >= 0; const bf16_t* src = ok ? vp - (size_t)j * P2LD : vp; const float mk = ok ? 1.0f : 0.0f;
#pragma unroll
            for (int ks = 0; ks < 4; ++ks) { const F8 x = ld_bf8(src + ks * 32);
#pragma unroll
                for (int e = 0; e < 8; ++e) sum[ks].v[e] += mk * x.v[e]; }
        } else {
            if (tt >= 0) {
#pragma unroll
                for (int ks = 0; ks < 4; ++ks) { const F8 x = ld_bf8(vp - (size_t)j * P2LD + ks * 32);
#pragma unroll
                    for (int e = 0; e < 8; ++e) sum[ks].v[e] += x.v[e]; }
            } else {
                const float* sp = p.spool + ((size_t)b * 15 + (15 + tt)) * DPL + gi * 128 + fq * 8;
#pragma unroll
                for (int ks = 0; ks < 4; ++ks) { const F8 x = ld_f8(sp + ks * 32);
#pragma unroll
                    for (int e = 0; e < 8; ++e) sum[ks].v[e] += x.v[e]; }
            }
        }
    }
    const int cnti = SAMP ? w : ((t + 1 < w) ? (t + 1) : w);
    const float ic = 1.0f / (float)cnti;
    bf16x8 af[4];
#pragma unroll
    for (int ks = 0; ks < 4; ++ks) {
        u32x4 o;
        o.x = cvt_pk_bf16(sum[ks].v[0] * ic - v0[ks].v[0], sum[ks].v[1] * ic - v0[ks].v[1]); o.y = cvt_pk_bf16(sum[ks].v[2] * ic - v0[ks].v[2], sum[ks].v[3] * ic - v0[ks].v[3]);
        o.z = cvt_pk_bf16(sum[ks].v[4] * ic - v0[ks].v[4], sum[ks].v[5] * ic - v0[ks].v[5]); o.w = cvt_pk_bf16(sum[ks].v[6] * ic - v0[ks].v[6], sum[ks].v[7] * ic - v0[ks].v[7]);
        af[ks] = __builtin_bit_cast(bf16x8, o);
    }
    const bf16_t* pw = PWT + (size_t)gi * 16384 + fr * 128 + fq * 8;
#pragma unroll 2
    for (int nb = 0; nb < 8; ++nb) {
        f32x4 acc = (f32x4){0.f, 0.f, 0.f, 0.f};
#pragma unroll
        for (int ks = 0; ks < 4; ++ks) {
            const bf16x8 bfrag = *(const bf16x8*)(pw + nb * 16 * 128 + ks * 32);
            acc = __builtin_amdgcn_mfma_f32_16x16x32_bf16(bfrag, af[ks], acc, 0, 0, 0);
        }
        const int col = gi * 128 + nb * 16 + fq * 4;
        const f32x4 sc = *(const f32x4*)(p.pool_scale + col);
        const u32x2 zw = *(const u32x2*)(P2 + (size_t)row * P2LD + 1536 + col);
        u32x2 o; o.x = cvt_pk_bf16(acc[0] * sc[0] * bf_lo(zw.x), acc[1] * sc[1] * bf_hi(zw.x)); o.y = cvt_pk_bf16(acc[2] * sc[2] * bf_lo(zw.y), acc[3] * sc[3] * bf_hi(zw.y));
        *(u32x2*)(YB + (size_t)row * DM + 512 + col) = o;
    }
}

__device__ __forceinline__ void phase_mix_prompt(const Params& p, int gw, int NGW, int lane) {
    asm volatile("" : "+v"(lane), "+s"(gw));
    const bf16_t* P2 = (const bf16_t*)(p.ws + WS_P2); const bf16_t* PWT = (const bf16_t*)(p.ws + WS_PW); bf16_t* YB = (bf16_t*)(p.ws + WS_YB);
    constexpr int NPOOL = (MP / 16) * 4, NCONV = MP / 8;
    for (int item = gw; item < NPOOL; item += NGW) pool_item<false>(p, P2, PWT, YB, item & (MP / 16 - 1), item / (MP / 16), lane);
    const ConvW cw = load_convw(p, lane * 8);
    for (int item = gw; item < NCONV; item += NGW) conv_item_prompt(P2, YB, cw, item * 8, lane * 8);
}
__device__ __forceinline__ void phase_mix_sample(const Params& p, int gw, int NGW, int lane) {
    asm volatile("" : "+v"(lane), "+s"(gw));
    const bf16_t* P2 = (const bf16_t*)(p.ws + WS_P2); const bf16_t* PWT = (const bf16_t*)(p.ws + WS_PW); bf16_t* YB = (bf16_t*)(p.ws + WS_YB);
    constexpr int NPOOL = (MS / 16) * 4;
    for (int item = gw; item < NPOOL + MS; item += NGW) {
        if (item < NPOOL) pool_item<true>(p, P2, PWT, YB, MP / 16 + (item >> 2), item & 3, lane);
        else { const ConvW cw = load_convw(p, lane * 8); conv_item_sample(p, P2, YB, cw, MP + (item - NPOOL), lane * 8); }
    }
}

__device__ __forceinline__ void phase_final(const Params& p, int r_lo, int r_hi, int gw, int NGW, int lane) {
    asm volatile("" : "+v"(lane), "+s"(gw));
    f32x4 g[4];
#pragma unroll
    for (int j = 0; j < 4; ++j) g[j] = *((const f32x4*)p.final_g + lane + 64 * j);
    for (int r = r_lo + gw; r < r_hi; r += 2 * NGW) {
        const int r2 = r + NGW; const bool has2 = r2 < r_hi; const int rb = has2 ? r2 : r;
        f32x4* rowa = (f32x4*)(p.out + (size_t)r * DM) + lane; f32x4* rowb = (f32x4*)(p.out + (size_t)rb * DM) + lane;
        f32x4 va[4], vb[4]; float sa = 0.f, sb = 0.f;
#pragma unroll
        for (int j = 0; j < 4; ++j) { va[j] = rowa[64 * j]; vb[j] = rowb[64 * j]; }
#pragma unroll
        for (int j = 0; j < 4; ++j) { sa += (va[j].x * va[j].x + va[j].y * va[j].y) + (va[j].z * va[j].z + va[j].w * va[j].w); sb += (vb[j].x * vb[j].x + vb[j].y * vb[j].y) + (vb[j].z * vb[j].z + vb[j].w * vb[j].w); }
        const float ra = rsqrtf(wave_sum(sa) * (1.0f / DM) + EPS), rbv = rsqrtf(wave_sum(sb) * (1.0f / DM) + EPS);
#pragma unroll
        for (int j = 0; j < 4; ++j) rowa[64 * j] = va[j] * ra * g[j];
        if (has2) {
#pragma unroll
            for (int j = 0; j < 4; ++j) rowb[64 * j] = vb[j] * rbv * g[j]; }
    }
}

constexpr int NS1 = 2 * (DIN / BM), NS2 = 2 * (DM / BM);

__global__ void __launch_bounds__(512, 2) fwd_megakernel(Params p) {
    extern __shared__ __attribute__((aligned(16))) unsigned char shm[];
    LAS unsigned char* lds = (LAS unsigned char*)shm;
    cg::grid_group grid = cg::this_grid();
    if (p.never) grid.sync();
    volatile LAS unsigned* xst = (volatile LAS unsigned*)(lds + STAGE_BYTES);
    if (threadIdx.x == 0) { xst[0] = 0u; xst[1] = 0u; }
    __syncthreads();
    const XcdBarrier xb = xcd_barrier_post((unsigned*)(p.ws + WS_BAR), xst);
    const int tid = threadIdx.x, wave = __builtin_amdgcn_readfirstlane(tid >> 6), lane = tid & 63;
    const int G = (int)gridDim.x, c = (int)blockIdx.x;
    const int gw = c * 8 + wave, NGW = G * 8;

    phase_prep(p, lds, gw, NGW, wave, lane);
    xcd_barrier(xb);
    { const Gemm g{(const bf16_t*)(p.ws + WS_XN), (const bf16_t*)(p.ws + WS_WIN), MT, DIN, DM};
      const EpiMix E{(bf16_t*)(p.ws + WS_P2), p.out};
      for (int pass = 0; pass < 2; ++pass) {
          Order S; if (pass == 0) S.init(MP / BM, DIN / BM, 0, G, c); else S.init(MS / BM, DIN / BM, MP / BM, G, c);
          gemm_phase(lds, g, S, E);
          if (pass == 1 && c >= NS1) phase_mix_prompt(p, (c - NS1) * 8 + wave, (G - NS1) * 8, lane);
          xcd_barrier(xb);
      } }
    phase_mix_sample(p, gw, NGW, lane);
    { const Gemm g{(const bf16_t*)(p.ws + WS_YB), (const bf16_t*)(p.ws + WS_WOUT), MT, DM, DM};
      const EpiOut E{p.out, p.xp, p.xs};
      for (int pass = 0; pass < 2; ++pass) {
          Order S; if (pass == 0) S.init(MP / BM, DM / BM, 0, G, c); else S.init(MS / BM, DM / BM, MP / BM, G, c);
          gemm_phase(lds, g, S, E);
          if (pass == 1 && c >= NS2) phase_final(p, 0, MP, (c - NS2) * 8 + wave, (G - NS2) * 8, lane);
          xcd_barrier(xb);
      } }
    phase_final(p, MP, MT, gw, NGW, lane);
}

extern "C" void kernel_launch(void* const* d_in, const int* in_sizes, int n_in, void* d_out, int out_size, void* d_ws, size_t ws_size, hipStream_t stream) {
    static int grid_blocks = 0;
    if (!grid_blocks) {
        int dev = 0, cus = 0, per_cu = 0;
        (void)hipGetDevice(&dev);
        (void)hipDeviceGetAttribute(&cus, hipDeviceAttributeMultiprocessorCount, dev);
        if (hipFuncSetAttribute((const void*)fwd_megakernel, hipFuncAttributeMaxDynamicSharedMemorySize, LDS_BYTES) != hipSuccess) fprintf(stderr, "hipFuncSetAttribute failed\n");
        (void)hipOccupancyMaxActiveBlocksPerMultiprocessor(&per_cu, (const void*)fwd_megakernel, 512, LDS_BYTES);
        if (per_cu < 1) { fprintf(stderr, "occupancy query says %d blocks/CU\n", per_cu); per_cu = 1; }
        grid_blocks = cus * per_cu;
        (void)hipGetLastError();
    }
    (void)hipMemsetAsync((char*)d_ws + WS_BAR, 0, XCD_BAR_WORDS * 4, stream);
    Params p{};
    p.xp = (const float*)d_in[0]; p.xs = (const float*)d_in[1]; p.sconv = (const float*)d_in[2]; p.spool = (const float*)d_in[3];
    p.norm_g = (const float*)d_in[4]; p.w_in = (const float*)d_in[5]; p.conv_w = (const float*)d_in[6]; p.pool_w = (const float*)d_in[7];
    p.pool_scale = (const float*)d_in[8]; p.w_out = (const float*)d_in[9]; p.final_g = (const float*)d_in[10];
    p.out = (float*)d_out; p.ws = (unsigned char*)d_ws;
    void* args[] = {&p};
    hipError_t e = hipLaunchCooperativeKernel((void*)fwd_megakernel, dim3(grid_blocks), dim3(512), args, LDS_BYTES, stream);
    if (e != hipSuccess) fprintf(stderr, "cooperative launch failed: %s (grid %d)\n", hipGetErrorString(e), grid_blocks);
}
```

```cpp
#include <hip/hip_runtime.h>
#include <hip/hip_cooperative_groups.h>
#include <cstdio>
namespace cg = cooperative_groups;

#define LAS __attribute__((address_space(3)))
typedef unsigned short bf16_t;
typedef short bf16x8 __attribute__((ext_vector_type(8)));
typedef float f32x4 __attribute__((ext_vector_type(4)));
typedef unsigned u32x4 __attribute__((ext_vector_type(4)));
typedef unsigned u32x2 __attribute__((ext_vector_type(2)));

constexpr int MP = 16384, MS = 512, MT = MP + MS, DM = 1024, DIN = 3072, DC = 512, DPL = 512;
constexpr int SEQ = 2048, DSEQ = 4;
constexpr float EPS = 1e-6f;
constexpr int BM = 256, BK = 64, HALF = 128, HTB = HALF * BK * 2, STAGE_BYTES = 8 * HTB, NXCD = 8, WGM = 8;
constexpr int LDS_BYTES = STAGE_BYTES + 16;

constexpr size_t WS_BAR = 0;
constexpr size_t WS_CNT = 16384;
constexpr size_t WS_CTL_BYTES = 36864;
constexpr size_t WS_XN = WS_CTL_BYTES;
constexpr size_t WS_WIN = WS_XN + (size_t)MT * DM * 2;
constexpr size_t WS_WOUT = WS_WIN + (size_t)DIN * DM * 2;
constexpr size_t WS_PW = WS_WOUT + (size_t)DM * DM * 2;
constexpr size_t WS_P2 = WS_PW + (size_t)4 * 128 * 128 * 2;
constexpr size_t WS_YB = WS_XN;
constexpr size_t WS_STATS = WS_P2 + (size_t)MT * 2048 * 2;
constexpr size_t WS_END = WS_STATS + (size_t)64 * 4 * 256 * 4;
constexpr int P2LD = 2048;

constexpr size_t O_Y = 0;
constexpr size_t O_CONVP = (size_t)MT * DM;
constexpr size_t O_POOLP = O_CONVP + 8 * 2 * 512;
constexpr size_t O_CONVS = O_POOLP + 8 * 15 * 512;
constexpr size_t O_POOLS = O_CONVS + 128 * 2 * 512;

constexpr int CTL_WORDS = 10240, CTL_CNT = 4096, CTL_EXIT = 10000, CTL_MIXS = CTL_CNT + 64 * 68 + 512;
__device__ unsigned g_ctl[CTL_WORDS];

struct Params {
    const float *xp, *xs, *sconv, *spool, *norm_g, *w_in, *conv_w, *pool_w, *pool_scale, *w_out, *final_g;
    float* out;
    unsigned char* ws;
    unsigned long long never;
};

typedef __bf16 bf16v2_t __attribute__((ext_vector_type(2)));
typedef float f32v2_t __attribute__((ext_vector_type(2)));
__device__ __forceinline__ unsigned cvt_pk_bf16(float lo, float hi) { const bf16v2_t r = __builtin_convertvector((f32v2_t){lo, hi}, bf16v2_t); return __builtin_bit_cast(unsigned, r); }
__device__ __forceinline__ unsigned pk_bf16_c(float lo, float hi) { return cvt_pk_bf16(lo, hi); }
__device__ __forceinline__ float bf_lo(unsigned w) { return __uint_as_float(w << 16); }
__device__ __forceinline__ float bf_hi(unsigned w) { return __uint_as_float(w & 0xffff0000u); }
__device__ __forceinline__ float wave_sum(float v) {
#pragma unroll
    for (int o = 1; o < 64; o <<= 1) v += __shfl_xor(v, o);
    return v;
}
__device__ __forceinline__ float silu(float z) { return z * __builtin_amdgcn_rcpf(1.0f + __builtin_amdgcn_exp2f(-1.4426950409f * z)); }

__device__ __forceinline__ void st_wt8(void* p, unsigned lo, unsigned hi) { __hip_atomic_store((unsigned long long*)p, ((unsigned long long)hi << 32) | lo, __ATOMIC_RELAXED, __HIP_MEMORY_SCOPE_AGENT); }
struct F8 { float v[8]; };
__device__ __forceinline__ F8 ld_bf8(const bf16_t* p) {
    const u32x4 w = *(const u32x4*)p; F8 r;
    r.v[0] = bf_lo(w.x); r.v[1] = bf_hi(w.x); r.v[2] = bf_lo(w.y); r.v[3] = bf_hi(w.y);
    r.v[4] = bf_lo(w.z); r.v[5] = bf_hi(w.z); r.v[6] = bf_lo(w.w); r.v[7] = bf_hi(w.w); return r;
}
__device__ __forceinline__ F8 ld_f8(const float* p) {
    const f32x4 a = *(const f32x4*)p, b = *(const f32x4*)(p + 4); F8 r;
    r.v[0] = a.x; r.v[1] = a.y; r.v[2] = a.z; r.v[3] = a.w; r.v[4] = b.x; r.v[5] = b.y; r.v[6] = b.z; r.v[7] = b.w; return r;
}
__device__ __forceinline__ void st_f8(float* p, const F8& r) {
    *(f32x4*)p = (f32x4){r.v[0], r.v[1], r.v[2], r.v[3]}; *(f32x4*)(p + 4) = (f32x4){r.v[4], r.v[5], r.v[6], r.v[7]};
}
__device__ __forceinline__ void st_bf8(bf16_t* p, const F8& r) {
    u32x4 w; w.x = cvt_pk_bf16(r.v[0], r.v[1]); w.y = cvt_pk_bf16(r.v[2], r.v[3]); w.z = cvt_pk_bf16(r.v[4], r.v[5]); w.w = cvt_pk_bf16(r.v[6], r.v[7]);
    *(u32x4*)p = w;
}


#define XB_TMO      128
#define XB_XCNT(j)  (256  + 64 * (j))
#define XB_XSUB(j)  (1280 + 64 * (j))
#define XB_XGEN(j)  (2304 + 64 * (j))
#define XB_TOP      3328
#define XB_TOPGEN   3392
#define XCD_BAR_WORDS 3456
#define XB_SPIN_CAP (1u << 18)
__device__ __forceinline__ unsigned xb_ld(unsigned* p)              { return __hip_atomic_load(p, __ATOMIC_RELAXED, __HIP_MEMORY_SCOPE_AGENT); }
__device__ __forceinline__ unsigned xb_add(unsigned* p, unsigned v) { return __hip_atomic_fetch_add(p, v, __ATOMIC_RELAXED, __HIP_MEMORY_SCOPE_AGENT); }
__device__ __forceinline__ unsigned xb_xcc_id() { return (unsigned)__builtin_amdgcn_s_getreg((3 << 11) | 20) & 0xFu; }
#define XB_SPIN(cond, bar) do { unsigned _sp = 0; while (cond) { __builtin_amdgcn_s_sleep(1); \
    if ((++_sp & 255u) == 0u) { if (xb_ld(&(bar)[XB_TMO])) break; if (_sp > XB_SPIN_CAP) { atomicAdd(&(bar)[XB_TMO], 1u); break; } } } } while (0)
struct XcdBarrier { unsigned* bar; unsigned x; volatile LAS unsigned* st; };
__device__ __forceinline__ XcdBarrier xcd_barrier_post(unsigned* bar, volatile LAS unsigned* st) {
    XcdBarrier b; b.bar = bar; b.x = xb_xcc_id(); b.st = st;
    if (threadIdx.x == 0) (void)xb_add(&bar[XB_XCNT(b.x)], 1u);
    return b;
}
__device__ __forceinline__ void xcd_barrier_complete(unsigned* bar, unsigned x, unsigned& nloc, unsigned& nx) {
    const unsigned G = gridDim.x * gridDim.y * gridDim.z;
    unsigned sum, cnt, mine, sp = 0u;
    for (;;) {
        sum = 0u; cnt = 0u; mine = 0u;
#pragma unroll
        for (unsigned j = 0; j < 16; ++j) { const unsigned c = xb_ld(&bar[XB_XCNT(j)]); sum += c; cnt += (c > 0u) ? 1u : 0u; mine = (j == x) ? c : mine; }
        if (sum == G) break;
        __builtin_amdgcn_s_sleep(1);
        if ((++sp & 255u) == 0u) { if (xb_ld(&bar[XB_TMO])) break; if (sp > XB_SPIN_CAP) { atomicAdd(&bar[XB_TMO], 1u); break; } }
    }
    nloc = mine > 0u ? mine : 1u; nx = cnt > 0u ? cnt : 1u;
}
__device__ __forceinline__ void xcd_barrier(const XcdBarrier& b, bool defer = false) {
    asm volatile("s_waitcnt vmcnt(0)" ::: "memory");
    __syncthreads();
    if (threadIdx.x == 0) {
        unsigned* bar = b.bar;
        unsigned bx = b.x;
        asm volatile("" : "+s"(bar), "+s"(bx));
        __builtin_amdgcn_s_waitcnt(0);
        unsigned nloc = b.st[0], nx = b.st[1];
        if (nloc == 0u) { xcd_barrier_complete(bar, bx, nloc, nx); b.st[0] = nloc; b.st[1] = nx; }
        const unsigned old = xb_add(&bar[XB_XSUB(bx)], 1u);
        const unsigned gen = old / nloc;
        if (old + 1u == (gen + 1u) * nloc) {
            __builtin_amdgcn_fence(__ATOMIC_RELEASE, "agent");
            asm volatile("s_waitcnt vmcnt(0)" ::: "memory");
            const unsigned og = xb_add(&bar[XB_TOP], 1u);
            const unsigned tg = og / nx;
            if (og + 1u == (tg + 1u) * nx) xb_add(&bar[XB_TOPGEN], 1u);
            else XB_SPIN(xb_ld(&bar[XB_TOPGEN]) == tg, bar);
            __builtin_amdgcn_fence(__ATOMIC_ACQUIRE, "agent");
            xb_add(&bar[XB_XGEN(bx)], 1u);
            asm volatile("s_waitcnt vmcnt(0)" ::: "memory");
        } else if (defer) {
            b.st[2] = gen; b.st[3] = 1u;
        } else {
            XB_SPIN(xb_ld(&bar[XB_XGEN(bx)]) == gen, bar);
            __builtin_amdgcn_fence(__ATOMIC_ACQUIRE, "agent");
            asm volatile("s_waitcnt vmcnt(0)" ::: "memory");
        }
    }
    __syncthreads();
}
__device__ __forceinline__ void xcd_barrier_finish(const XcdBarrier& b) {
    __syncthreads();
    if (threadIdx.x == 0 && b.st[3] != 0u) {
        unsigned* bar = b.bar; unsigned bx = b.x;
        asm volatile("" : "+s"(bar), "+s"(bx));
        const unsigned gen = b.st[2];
        XB_SPIN(xb_ld(&bar[XB_XGEN(bx)]) == gen, bar);
        __builtin_amdgcn_fence(__ATOMIC_ACQUIRE, "agent");
        asm volatile("s_waitcnt vmcnt(0)" ::: "memory");
        b.st[3] = 0u;
    }
    __syncthreads();
}

__host__ __device__ __forceinline__ int lds_byte(int r, int c) { const int st = (r >> 4) * 2 + (c >> 5), rr = r & 15, cc = c & 31, ob = rr * 64 + cc * 2; return st * 1024 + (ob ^ (((ob >> 9) & 1) << 5)); }
__host__ __device__ __forceinline__ void stage_rc(int b, int& R, int& C) { const int st = b / 1024, sb = b % 1024, swz = sb ^ (((sb >> 9) & 1) << 5); R = (st >> 1) * 16 + swz / 64; C = (st & 1) * 32 + (swz % 64) / 2; }
__host__ __device__ __forceinline__ int perm32(int rho) { const int n = rho >> 4, i = rho & 15; return 8 * (i >> 2) + 4 * n + (i & 3); }

struct Unit { int pm, pn, row0; };
struct Gemm { const bf16_t* A; const bf16_t* Bt; int M, N, K; };

struct Order {
    int nM, nN, nwg, G, c, pm0, rbase, rstep;
    __device__ void init(int nM_, int nN_, int pm0_, int G_, int c_, int rbase_ = 0, int rstep_ = BM) { nM = nM_; nN = nN_; nwg = nM * nN; G = G_; c = c_; pm0 = pm0_; rbase = rbase_; rstep = rstep_; }
    __device__ bool next(int i, Unit& u) const {
        const long L = (long)i * G + c; if (L >= nwg) return false;
        int wgid = (int)L; { const int q = nwg / NXCD, r = nwg % NXCD, xcd = wgid % NXCD, off = wgid / NXCD; wgid = (xcd < r ? xcd * (q + 1) : r * (q + 1) + (xcd - r) * q) + off; }
        const int nig = WGM * nN, gid = wgid / nig, fm = gid * WGM, gsz = (nM - fm) < WGM ? (nM - fm) : WGM;
        const int tr = fm + ((wgid % nig) % gsz); u.pm = pm0 + tr; u.pn = (wgid % nig) / gsz; u.row0 = rbase + rstep * tr; return true;
    }
};

struct EpiMix {
    static constexpr bool PERM = true, AFTER_DRAIN = false;
    bf16_t* P2; float* out; int nai;
    __device__ __forceinline__ void operator()(const f32x4 (&acc)[2][2][4][2], const Unit& u, int wr, int wc, int fr, int fq) const {
        const int ty = u.pn >> 2, loc = (u.pn & 3) * 128 + wc * 32 + 8 * fq;
        const int rowt = u.row0 + wr * 64 + fr;
#pragma unroll
        for (int ai = 0; ai < 2; ++ai) if (ai < nai)
#pragma unroll
            for (int m = 0; m < 4; ++m) {
                const int row = rowt + ai * HALF + m * 16;
                bf16_t* prow = P2 + (size_t)row * P2LD + loc;
                F8 a, b;
#pragma unroll
                for (int i = 0; i < 4; ++i) { a.v[i] = acc[ai][0][m][0][i]; a.v[4 + i] = acc[ai][0][m][1][i]; b.v[i] = acc[ai][1][m][0][i]; b.v[4 + i] = acc[ai][1][m][1][i]; }
                int sb, st; bool samp = row >= MP;
                if (!samp) { sb = row >> 11; st = row & (SEQ - 1); } else { const int q = row - MP; sb = q >> 2; st = q & 3; }
                if (ty == 0) {
                    F8 cu;
#pragma unroll
                    for (int i = 0; i < 8; ++i) cu.v[i] = a.v[i] * b.v[i];
                    st_bf8(prow, cu);
                    if (!samp) { if (st >= SEQ - 2) st_f8(out + O_CONVP + ((size_t)sb * 2 + (st - (SEQ - 2))) * DC + loc, cu); }
                    else if (st >= 2) st_f8(out + O_CONVS + ((size_t)sb * 2 + (st - 2)) * DC + loc, cu);
                } else if (ty == 1) {
                    F8 bs;
#pragma unroll
                    for (int i = 0; i < 8; ++i) bs.v[i] = a.v[i] * silu(b.v[i]);
                    st_bf8(prow + 512, bs);
                } else {
                    F8 zs;
#pragma unroll
                    for (int i = 0; i < 8; ++i) zs.v[i] = silu(b.v[i]);
                    st_bf8(prow + 1024, a); st_bf8(prow + 1536, zs);
                    if (!samp) { if (st >= SEQ - 15) st_f8(out + O_POOLP + ((size_t)sb * 15 + (st - (SEQ - 15))) * DPL + loc, a); }
                    else st_f8(out + O_POOLS + ((size_t)sb * 15 + 11 + st) * DPL + loc, a);
                }
            }
    }
};
struct EpiOut {
    static constexpr bool PERM = false, AFTER_DRAIN = false;
    float* out; const float* xp; const float* xs;
    __device__ __forceinline__ void operator()(const f32x4 (&acc)[2][2][4][2], const Unit& u, int wr, int wc, int fr, int fq) const {
        const int row0 = u.row0 + wr * 64 + fr, col0 = u.pn * BM + wc * 32 + 4 * fq;
        const float* xbase = (u.row0 < MP) ? xp : (xs - (size_t)MP * DM);
#pragma unroll
        for (int ai = 0; ai < 2; ++ai)
#pragma unroll
            for (int m = 0; m < 4; ++m) { const size_t ro = (size_t)(row0 + ai * HALF + m * 16) * DM + col0; float* rowp = out + ro; const float* xr = xbase + ro;
#pragma unroll
                for (int bj = 0; bj < 2; ++bj)
#pragma unroll
                    for (int n = 0; n < 2; ++n) *(f32x4*)(rowp + bj * HALF + n * 16) = acc[ai][bj][m][n] + *(const f32x4*)(xr + bj * HALF + n * 16); }
    }
};

struct EpiOutNorm {
    static constexpr bool PERM = false, AFTER_DRAIN = true;
    float* out; const float* xp; const float* fg; float* stats; unsigned* cnt; unsigned* tmo;
    __device__ __forceinline__ void operator()(const f32x4 (&)[2][2][4][2], const Unit&, int, int, int, int) const {}
    __device__ __forceinline__ void fused(f32x4 (&acc)[2][2][4][2], const Unit& u, int wr, int wc, int fr, int fq, LAS unsigned char* lds, int tid) const {
        LAS float* P = (LAS float*)lds;
        LAS float* Sv = (LAS float*)(lds + 4096);
        const int rl0 = wr * 64 + fr, col0 = u.pn * BM + wc * 32 + 4 * fq;
        const size_t rbase = (size_t)(u.row0 + rl0) * DM + col0;
        f32x4 gv[2][2];
#pragma unroll
        for (int bj = 0; bj < 2; ++bj)
#pragma unroll
            for (int n = 0; n < 2; ++n) gv[bj][n] = *(const f32x4*)(fg + col0 + bj * HALF + n * 16);
#pragma unroll
        for (int ai = 0; ai < 2; ++ai) {
            f32x4 xv[4][2][2];
#pragma unroll
            for (int m = 0; m < 4; ++m) { const float* xr = xp + rbase + (size_t)(ai * HALF + m * 16) * DM;
#pragma unroll
                for (int bj = 0; bj < 2; ++bj)
#pragma unroll
                    for (int n = 0; n < 2; ++n) xv[m][bj][n] = __builtin_nontemporal_load((const f32x4*)(xr + bj * HALF + n * 16)); }
#pragma unroll
            for (int m = 0; m < 4; ++m) { float s = 0.f;
#pragma unroll
                for (int bj = 0; bj < 2; ++bj)
#pragma unroll
                    for (int n = 0; n < 2; ++n) { const f32x4 h = acc[ai][bj][m][n] + xv[m][bj][n]; acc[ai][bj][m][n] = h; s += (h[0] * h[0] + h[1] * h[1]) + (h[2] * h[2] + h[3] * h[3]); }
                s += __shfl_xor(s, 16); s += __shfl_xor(s, 32);
                if (fq == 0) P[(ai * HALF + rl0 + m * 16) * 4 + wc] = s; }
        }
        asm volatile("s_waitcnt lgkmcnt(0)" ::: "memory"); __builtin_amdgcn_s_barrier(); asm volatile("" ::: "memory");
        float* slot = stats + (size_t)(u.pm * 4) * 256;
        if (tid < 256) { const float tot = (P[tid * 4 + 0] + P[tid * 4 + 1]) + (P[tid * 4 + 2] + P[tid * 4 + 3]);
            __hip_atomic_store(slot + u.pn * 256 + tid, tot, __ATOMIC_RELAXED, __HIP_MEMORY_SCOPE_AGENT); }
        asm volatile("s_waitcnt vmcnt(0)" ::: "memory"); __builtin_amdgcn_s_barrier(); asm volatile("" ::: "memory");
        if (tid == 0) {
            unsigned* c = cnt + 64 * u.pm;
            (void)xb_add(c, 1u);
            unsigned sp = 0;
            while (xb_ld(c) < 4u) { __builtin_amdgcn_s_sleep(1); if ((++sp & 255u) == 0u) { if (xb_ld(tmo)) break; if (sp > XB_SPIN_CAP) { atomicAdd(tmo, 1u); break; } } }
        }
        asm volatile("" ::: "memory"); __builtin_amdgcn_s_barrier(); asm volatile("" ::: "memory");
        if (tid < 256) { float tot = 0.f;
#pragma unroll
            for (int q = 0; q < 4; ++q) tot += __hip_atomic_load(slot + q * 256 + tid, __ATOMIC_RELAXED, __HIP_MEMORY_SCOPE_AGENT);
            Sv[tid] = rsqrtf(tot * (1.0f / DM) + EPS); }
        asm volatile("s_waitcnt lgkmcnt(0)" ::: "memory"); __builtin_amdgcn_s_barrier(); asm volatile("" ::: "memory");
#pragma unroll
        for (int ai = 0; ai < 2; ++ai)
#pragma unroll
            for (int m = 0; m < 4; ++m) {
                const float r = Sv[ai * HALF + rl0 + m * 16];
                float* orow = out + rbase + (size_t)(ai * HALF + m * 16) * DM;
#pragma unroll
                for (int bj = 0; bj < 2; ++bj)
#pragma unroll
                    for (int n = 0; n < 2; ++n) *(f32x4*)(orow + bj * HALF + n * 16) = acc[ai][bj][m][n] * r * gv[bj][n];
            }
    }
};

template <class Epi, class Sched, bool HALFM = false>
__device__ __forceinline__ void gemm_phase(LAS unsigned char* lds, const Gemm g, const Sched& S, const Epi& E) {
    const int tid = threadIdx.x, wid = __builtin_amdgcn_readfirstlane(tid >> 6), lane = tid & 63, wr = wid >> 2, wc = wid & 3, fr = lane & 15, fq = lane >> 4;
    const int K = g.K, nt = K / BK;
    unsigned voffA[2], voffB[2];
#pragma unroll
    for (int i = 0; i < 2; ++i) { int R, C; stage_rc(tid * 16 + i * 8192, R, C); const int Rb = Epi::PERM ? ((R & ~31) + perm32(R & 31)) : R;
        voffA[i] = (unsigned)(R * K + C) * 2u; voffB[i] = (unsigned)(Rb * K + C) * 2u; }
    const size_t kstep = (size_t)(BK * 2);
    const size_t hstep = (size_t)HALF * K * 2;
    const size_t tstep = 2 * hstep;
    const unsigned ldsw = (unsigned)wid * 1024u;
    const int aoff = lds_byte(wr * 64 + fr, fq * 8), boff = lds_byte(wc * 32 + fr, fq * 8);
#define PG8_SA(b, h) (((b) * 2 + (h)) * HTB)
#define PG8_SB(b, h) ((4 + (b) * 2 + (h)) * HTB)
#define PG8_STAGE(bufoff, gbase, voff) do { _Pragma("unroll") for (int _i = 0; _i < 2; ++_i) \
        __builtin_amdgcn_global_load_lds((const unsigned*)((const char*)(gbase) + (voff)[_i]), (LAS unsigned*)(lds + (bufoff) + ldsw + _i * 8192), 16, 0, 0); } while (0)
#define PG8_LDA(dst, b, h) do { _Pragma("unroll") for (int m = 0; m < 4; ++m) _Pragma("unroll") for (int k = 0; k < 2; ++k) dst[m][k] = *(const LAS bf16x8*)(lds + PG8_SA(b, h) + aoff + m * 2048 + k * 1024); } while (0)
#define PG8_LDB(dst, b, h) do { _Pragma("unroll") for (int n = 0; n < 2; ++n) _Pragma("unroll") for (int k = 0; k < 2; ++k) dst[n][k] = *(const LAS bf16x8*)(lds + PG8_SB(b, h) + boff + n * 2048 + k * 1024); } while (0)
#define PG8_MMA(ai, bj, At, Bt) do { __builtin_amdgcn_s_setprio(1); _Pragma("unroll") for (int m = 0; m < 4; ++m) _Pragma("unroll") for (int n = 0; n < 2; ++n) _Pragma("unroll") for (int k = 0; k < 2; ++k) \
        acc[ai][bj][m][n] = __builtin_amdgcn_mfma_f32_16x16x32_bf16(Bt[n][k], At[m][k], acc[ai][bj][m][n], 0, 0, 0); __builtin_amdgcn_s_setprio(0); } while (0)
#define PG8_WAIT_V(n) asm volatile("s_waitcnt vmcnt(" #n ")" ::: "memory")
#define PG8_WAIT_L(n) asm volatile("s_waitcnt lgkmcnt(" #n ")" ::: "memory")
#define PG8_BAR __builtin_amdgcn_s_barrier()
#define PG8_SCHED __builtin_amdgcn_sched_barrier(0)
    Unit cur, nxt; int ui = 0;
    if (!S.next(0, cur)) return;
    f32x4 acc[2][2][4][2];
#pragma unroll
    for (int a = 0; a < 2; ++a)
#pragma unroll
        for (int b = 0; b < 2; ++b)
#pragma unroll
            for (int m = 0; m < 4; ++m)
#pragma unroll
                for (int n = 0; n < 2; ++n) acc[a][b][m][n] = (f32x4){0.f, 0.f, 0.f, 0.f};
    bf16x8 At[4][2], B0[2][2], B1[2][2];
    const size_t rowb = (size_t)K * 2;
    const char* cA = (const char*)g.A + (size_t)cur.row0 * rowb; const char* cB = (const char*)g.Bt + (size_t)cur.pn * tstep;
    PG8_STAGE(PG8_SB(0, 0), cB, voffB); PG8_STAGE(PG8_SA(0, 0), cA, voffA); PG8_STAGE(PG8_SB(0, 1), cB + hstep, voffB); PG8_STAGE(PG8_SA(0, 1), cA + hstep, voffA);
    if (wr == 1) PG8_BAR;
    PG8_WAIT_V(4); PG8_BAR;
    PG8_STAGE(PG8_SB(1, 0), cB + kstep, voffB); PG8_STAGE(PG8_SA(1, 0), cA + kstep, voffA); PG8_STAGE(PG8_SB(1, 1), cB + hstep + kstep, voffB);
    PG8_WAIT_V(6); PG8_BAR;
    for (;;) {
        const bool has_next = S.next(ui + 1, nxt);
        const char* nA = has_next ? (const char*)g.A + (size_t)nxt.row0 * rowb : cA; const char* nB = has_next ? (const char*)g.Bt + (size_t)nxt.pn * tstep : cB;
        for (int t = 0; t < nt; t += 2) {
            const bool last = (t == nt - 2);
            const char* a1 = cA + (size_t)(t + 1) * kstep;
            const char* a2 = last ? nA : cA + (size_t)(t + 2) * kstep; const char* b2 = last ? nB : cB + (size_t)(t + 2) * kstep;
            const char* a3 = a2 + kstep; const char* b3 = b2 + kstep;
            PG8_LDB(B0, 0, 0); PG8_SCHED; PG8_LDA(At, 0, 0); PG8_STAGE(PG8_SA(1, 1), a1 + hstep, voffA);
            PG8_WAIT_L(8); PG8_BAR; PG8_WAIT_L(0); PG8_MMA(0, 0, At, B0); PG8_BAR; PG8_SCHED;
            PG8_LDB(B1, 0, 1); PG8_STAGE(PG8_SB(0, 0), b2, voffB);
            PG8_BAR; PG8_WAIT_L(0); PG8_MMA(0, 1, At, B1); PG8_BAR;
            if (!HALFM) PG8_LDA(At, 0, 1); PG8_STAGE(PG8_SA(0, 0), a2, voffA);
            PG8_BAR; PG8_WAIT_L(0); if (!HALFM) PG8_MMA(1, 0, At, B0); PG8_BAR; PG8_SCHED;
            PG8_STAGE(PG8_SB(0, 1), b2 + hstep, voffB);
            PG8_WAIT_V(6); PG8_BAR; if (!HALFM) PG8_MMA(1, 1, At, B1); PG8_BAR;
            PG8_LDB(B0, 1, 0); PG8_SCHED; PG8_LDA(At, 1, 0); PG8_STAGE(PG8_SA(0, 1), a2 + hstep, voffA);
            PG8_WAIT_L(8); PG8_BAR; PG8_WAIT_L(0); PG8_MMA(0, 0, At, B0); PG8_BAR; PG8_SCHED;
            PG8_LDB(B1, 1, 1); PG8_STAGE(PG8_SB(1, 0), b3, voffB);
            PG8_BAR; PG8_WAIT_L(0); PG8_MMA(0, 1, At, B1); PG8_BAR;
            if (!HALFM) PG8_LDA(At, 1, 1); PG8_STAGE(PG8_SA(1, 0), a3, voffA);
            PG8_BAR; PG8_WAIT_L(0); if (!HALFM) PG8_MMA(1, 0, At, B0); PG8_BAR; PG8_SCHED;
            PG8_STAGE(PG8_SB(1, 1), b3 + hstep, voffB);
            PG8_WAIT_V(6); PG8_BAR; if (!HALFM) PG8_MMA(1, 1, At, B1); PG8_BAR;
        }
        if constexpr (!Epi::AFTER_DRAIN) E(acc, cur, wr, wc, fr, fq);
        if (!has_next) break;
#pragma unroll
        for (int a = 0; a < 2; ++a)
#pragma unroll
            for (int b = 0; b < 2; ++b)
#pragma unroll
                for (int m = 0; m < 4; ++m)
#pragma unroll
                    for (int n = 0; n < 2; ++n) acc[a][b][m][n] = (f32x4){0.f, 0.f, 0.f, 0.f};
        cur = nxt; cA = nA; cB = nB; ++ui;
    }
    PG8_WAIT_V(0);
    if (wr == 0) PG8_BAR;
    PG8_BAR;
    if constexpr (Epi::AFTER_DRAIN) E.fused(acc, cur, wr, wc, fr, fq, lds, tid);
#undef PG8_SA
#undef PG8_SB
#undef PG8_STAGE
#undef PG8_LDA
#undef PG8_LDB
#undef PG8_MMA
#undef PG8_WAIT_V
#undef PG8_WAIT_L
#undef PG8_BAR
#undef PG8_SCHED
}

__device__ __forceinline__ void p0_transpose_item(const float* W, int K, int N, bf16_t* WT, LAS float* scr, int k0, int nsrc0, int ndst0, int lane) {
    float wv[32];
#pragma unroll
    for (int i = 0; i < 32; ++i) wv[i] = __builtin_nontemporal_load(W + (size_t)(k0 + 2 * i + (lane >> 5)) * N + nsrc0 + (lane & 31));
#pragma unroll
    for (int i = 0; i < 32; ++i) scr[(2 * i + (lane >> 5)) * 33 + (lane & 31)] = wv[i];
    asm volatile("s_waitcnt lgkmcnt(0)" ::: "memory");
    const int c = lane & 7;
#pragma unroll
    for (int j = 0; j < 4; ++j) { const int n = (lane >> 3) + 8 * j; const LAS float* s = scr + (8 * c) * 33 + n;
        u32x4 o; o.x = cvt_pk_bf16(s[0 * 33], s[1 * 33]); o.y = cvt_pk_bf16(s[2 * 33], s[3 * 33]); o.z = cvt_pk_bf16(s[4 * 33], s[5 * 33]); o.w = cvt_pk_bf16(s[6 * 33], s[7 * 33]);
        *(u32x4*)(WT + (size_t)(ndst0 + n) * K + k0 + 8 * c) = o; }
    asm volatile("s_waitcnt lgkmcnt(0)" ::: "memory");
}
__device__ __forceinline__ int win_src_col(int np) {
    const int pn = np >> 8, half = (np >> 7) & 1, ty = pn >> 2, ch = (pn & 3) * 128 + (np & 127);
    return ty == 0 ? (half ? 1024 + ch : 512 + ch) : ty == 1 ? (half ? 1536 + ch : ch) : (half ? 2560 + ch : 2048 + ch);
}

__device__ __forceinline__ void phase_prep(const Params& p, LAS unsigned char* lds, int gw, int NGW, int wave, int lane) {
    asm volatile("" : "+v"(lane), "+s"(gw), "+s"(wave));
    bf16_t* XN = (bf16_t*)(p.ws + WS_XN);
    LAS float* scr = (LAS float*)(lds + wave * 16384);
    constexpr int I_IN = (DM / 64) * (DIN / 32), I_OUT = (DM / 64) * (DM / 32), I_PW = 4 * (128 / 64) * (128 / 32);
    for (int it = gw; it < I_IN + I_PW; it += NGW) {
        int r = it;
        if (r < I_IN) { const int kb = r / (DIN / 32), nb = r % (DIN / 32); p0_transpose_item(p.w_in, DM, DIN, (bf16_t*)(p.ws + WS_WIN), scr, 64 * kb, win_src_col(32 * nb), 32 * nb, lane); continue; } r -= I_IN;
        const int gidx = r >> 3, q = r & 7; p0_transpose_item(p.pool_w + gidx * 16384, 128, 128, (bf16_t*)(p.ws + WS_PW) + gidx * 16384, scr, 64 * (q >> 2), 32 * (q & 3), 32 * (q & 3), lane);
    }
    f32x4 g[4];
#pragma unroll
    for (int j = 0; j < 4; ++j) g[j] = *((const f32x4*)p.norm_g + lane + 64 * j);
    for (int r = gw; r < MT; r += 2 * NGW) {
        const int r2 = r + NGW; const bool has2 = r2 < MT; const int rb = has2 ? r2 : r;
        const float* xa = (r < MP) ? p.xp + (size_t)r * DM : p.xs + (size_t)(r - MP) * DM;
        const float* xb = (rb < MP) ? p.xp + (size_t)rb * DM : p.xs + (size_t)(rb - MP) * DM;
        f32x4 va[4], vb[4]; float sa = 0.f, sb = 0.f;
#pragma unroll
        for (int j = 0; j < 4; ++j) { va[j] = __builtin_nontemporal_load((const f32x4*)xa + lane + 64 * j); vb[j] = __builtin_nontemporal_load((const f32x4*)xb + lane + 64 * j); }
#pragma unroll
        for (int j = 0; j < 4; ++j) { sa += (va[j].x * va[j].x + va[j].y * va[j].y) + (va[j].z * va[j].z + va[j].w * va[j].w); sb += (vb[j].x * vb[j].x + vb[j].y * vb[j].y) + (vb[j].z * vb[j].z + vb[j].w * vb[j].w); }
        const float ra = rsqrtf(wave_sum(sa) * (1.0f / DM) + EPS), rbv = rsqrtf(wave_sum(sb) * (1.0f / DM) + EPS);
        u32x2* oa = (u32x2*)(XN + (size_t)r * DM) + lane; u32x2* ob = (u32x2*)(XN + (size_t)rb * DM) + lane;
#pragma unroll
        for (int j = 0; j < 4; ++j) { u32x2 w; w.x = cvt_pk_bf16(va[j].x * ra * g[j].x, va[j].y * ra * g[j].y); w.y = cvt_pk_bf16(va[j].z * ra * g[j].z, va[j].w * ra * g[j].w); oa[64 * j] = w; }
        if (has2) {
#pragma unroll
            for (int j = 0; j < 4; ++j) { u32x2 w; w.x = cvt_pk_bf16(vb[j].x * rbv * g[j].x, vb[j].y * rbv * g[j].y); w.y = cvt_pk_bf16(vb[j].z * rbv * g[j].z, vb[j].w * rbv * g[j].w); ob[64 * j] = w; } }
    }
}
__device__ __forceinline__ void phase_late_prep(const Params& p, LAS unsigned char* lds, int gw, int NGW, int wave, int lane) {
    asm volatile("" : "+v"(lane), "+s"(gw), "+s"(wave));
    LAS float* scr = (LAS float*)(lds + wave * 16384);
    constexpr int I_OUT = (DM / 64) * (DM / 32);
    for (int r = gw; r < I_OUT; r += NGW) { const int kb = r / (DM / 32), nb = r % (DM / 32); p0_transpose_item(p.w_out, DM, DM, (bf16_t*)(p.ws + WS_WOUT), scr, 64 * kb, 32 * nb, 32 * nb, lane); }
    for (int i = gw * 64 + lane; i < 128 * 11 * 128; i += NGW * 64) {
        const int b = i / (11 * 128), rem = i - b * (11 * 128);
        *((f32x4*)(p.out + O_POOLS + (size_t)b * 15 * DPL) + rem) = *((const f32x4*)(p.spool + ((size_t)b * 15 + 4) * DPL) + rem);
    }
}

__device__ __forceinline__ F8 unpack8(const u32x4 w) { F8 r;
    r.v[0] = bf_lo(w.x); r.v[1] = bf_hi(w.x); r.v[2] = bf_lo(w.y); r.v[3] = bf_hi(w.y); r.v[4] = bf_lo(w.z); r.v[5] = bf_hi(w.z); r.v[6] = bf_lo(w.w); r.v[7] = bf_hi(w.w); return r; }

struct ConvW { F8 w0, w1, w2; };
__device__ __forceinline__ ConvW load_convw(const Params& p, int c0) { ConvW c; c.w0 = ld_f8(p.conv_w + c0); c.w1 = ld_f8(p.conv_w + DC + c0); c.w2 = ld_f8(p.conv_w + 2 * DC + c0); return c; }

__device__ __forceinline__ void conv_item_prompt(const bf16_t* P2, bf16_t* YB, const ConvW& cw, int r0, int c0) {
    const bf16_t* base = P2 + (size_t)r0 * P2LD + c0;
    u32x4 cuw[10], bsw[8];
    const u32x4 z4 = (u32x4){0u, 0u, 0u, 0u};
    if ((r0 & (SEQ - 1)) != 0) { cuw[0] = *(const u32x4*)(base - 2 * P2LD); cuw[1] = *(const u32x4*)(base - P2LD); } else { cuw[0] = z4; cuw[1] = z4; }
#pragma unroll
    for (int i = 0; i < 8; ++i) { cuw[2 + i] = *(const u32x4*)(base + i * P2LD); bsw[i] = *(const u32x4*)(base + i * P2LD + 512); }
    F8 c2 = unpack8(cuw[0]), c1 = unpack8(cuw[1]);
#pragma unroll
    for (int i = 0; i < 8; ++i) {
        const F8 c0v = unpack8(cuw[2 + i]), bs = unpack8(bsw[i]); F8 y;
#pragma unroll
        for (int e = 0; e < 8; ++e) y.v[e] = bs.v[e] * (cw.w0.v[e] * c2.v[e] + cw.w1.v[e] * c1.v[e] + cw.w2.v[e] * c0v.v[e]);
        { u32x4 wq; wq.x = cvt_pk_bf16(y.v[0], y.v[1]); wq.y = cvt_pk_bf16(y.v[2], y.v[3]); wq.z = cvt_pk_bf16(y.v[4], y.v[5]); wq.w = cvt_pk_bf16(y.v[6], y.v[7]); *(u32x4*)(YB + (size_t)(r0 + i) * DM + c0) = wq; }
        c2 = c1; c1 = c0v;
    }
}
__device__ __forceinline__ void conv_item_sample(const Params& p, const bf16_t* P2, bf16_t* YB, const ConvW& cw, int row, int c0) {
    const int q = row - MP, b = q >> 2, t = q & 3;
    const bf16_t* base = P2 + (size_t)row * P2LD + c0;
    const F8 c0v = ld_bf8(base), bs = ld_bf8(base + 512);
    F8 c1, c2;
    if (t >= 1) c1 = ld_bf8(base - P2LD); else c1 = ld_f8(p.sconv + ((size_t)b * 2 + 1) * DC + c0);
    if (t >= 2) c2 = ld_bf8(base - 2 * P2LD); else c2 = ld_f8(p.sconv + ((size_t)b * 2 + t) * DC + c0);
    F8 y;
#pragma unroll
    for (int e = 0; e < 8; ++e) y.v[e] = bs.v[e] * (cw.w0.v[e] * c2.v[e] + cw.w1.v[e] * c1.v[e] + cw.w2.v[e] * c0v.v[e]);
    { bf16_t* d = YB + (size_t)row * DM + c0;
      st_wt8(d, cvt_pk_bf16(y.v[0], y.v[1]), cvt_pk_bf16(y.v[2], y.v[3])); st_wt8(d + 4, cvt_pk_bf16(y.v[4], y.v[5]), cvt_pk_bf16(y.v[6], y.v[7])); }
    asm volatile("s_waitcnt vmcnt(0)" ::: "memory");
    if ((c0 >> 3) == 0) (void)xb_add(g_ctl + CTL_MIXS + 8 * (q >> 4), 1u);
}
__device__ __forceinline__ void pool_item_sample(const Params& p, const bf16_t* P2, const bf16_t* PWT, bf16_t* YB, int rb, int gi, int lane) {
    const int fr = lane & 15, fq = lane >> 4;
    const int row = rb * 16 + fr, w = 2 << gi;
    const int q = row - MP, b = q >> 2, t = q & 3;
    const bf16_t* vp = P2 + (size_t)row * P2LD + 1024 + gi * 128 + fq * 8;
    const float* sp = p.spool + (size_t)b * 15 * DPL + gi * 128 + fq * 8;
    F8 v0[4], sum[4];
#pragma unroll
    for (int ks = 0; ks < 4; ++ks) { v0[ks] = ld_bf8(vp + ks * 32); sum[ks] = v0[ks]; }
#pragma unroll
    for (int j = 1; j < 4; ++j) {
        if (j < w) {
            const bool ok = (t - j) >= 0;
            const bf16_t* bsrc = ok ? vp - (ptrdiff_t)j * P2LD : vp;
            const float* ssrc = sp + (ok ? 0 : (15 + t - j)) * DPL;
#pragma unroll
            for (int ks = 0; ks < 4; ++ks) { const F8 xb = ld_bf8(bsrc + ks * 32), xs = ld_f8(ssrc + ks * 32);
#pragma unroll
                for (int e = 0; e < 8; ++e) sum[ks].v[e] += ok ? xb.v[e] : xs.v[e]; }
        }
    }
#pragma unroll 4
    for (int j = 4; j < w; ++j) {
        const float* ssrc = sp + (15 + t - j) * DPL;
#pragma unroll
        for (int ks = 0; ks < 4; ++ks) { const F8 xs = ld_f8(ssrc + ks * 32);
#pragma unroll
            for (int e = 0; e < 8; ++e) sum[ks].v[e] += xs.v[e]; }
    }
    const float ic = 1.0f / (float)w;
    bf16x8 af[4];
#pragma unroll
    for (int ks = 0; ks < 4; ++ks) {
        u32x4 o;
        o.x = cvt_pk_bf16(sum[ks].v[0] * ic - v0[ks].v[0], sum[ks].v[1] * ic - v0[ks].v[1]); o.y = cvt_pk_bf16(sum[ks].v[2] * ic - v0[ks].v[2], sum[ks].v[3] * ic - v0[ks].v[3]);
        o.z = cvt_pk_bf16(sum[ks].v[4] * ic - v0[ks].v[4], sum[ks].v[5] * ic - v0[ks].v[5]); o.w = cvt_pk_bf16(sum[ks].v[6] * ic - v0[ks].v[6], sum[ks].v[7] * ic - v0[ks].v[7]);
        af[ks] = __builtin_bit_cast(bf16x8, o);
    }
    const bf16_t* pw = PWT + (size_t)gi * 16384 + fr * 128 + fq * 8;
#pragma unroll 4
    for (int nb = 0; nb < 8; ++nb) {
        f32x4 acc = (f32x4){0.f, 0.f, 0.f, 0.f};
#pragma unroll
        for (int ks = 0; ks < 4; ++ks) {
            const bf16x8 bfrag = *(const bf16x8*)(pw + nb * 16 * 128 + ks * 32);
            acc = __builtin_amdgcn_mfma_f32_16x16x32_bf16(bfrag, af[ks], acc, 0, 0, 0);
        }
        const int col = gi * 128 + nb * 16 + fq * 4;
        const f32x4 sc = *(const f32x4*)(p.pool_scale + col);
        const u32x2 zw = *(const u32x2*)(P2 + (size_t)row * P2LD + 1536 + col);
        u32x2 o; o.x = cvt_pk_bf16(acc[0] * sc[0] * bf_lo(zw.x), acc[1] * sc[1] * bf_hi(zw.x)); o.y = cvt_pk_bf16(acc[2] * sc[2] * bf_lo(zw.y), acc[3] * sc[3] * bf_hi(zw.y));
        *(u32x2*)(YB + (size_t)row * DM + 512 + col) = o;
    }
}

constexpr int PT_ROWS = 80, PT_ROWB = 272, PT_VBYTES = PT_ROWS * PT_ROWB, PT_WBYTES = 128 * PT_ROWB, PT_BUF = PT_VBYTES + PT_WBYTES;
struct PoolRegs { u32x4 v[3]; u32x4 w[4]; u32x2 zs[4]; };
__device__ __forceinline__ void pool_load(const bf16_t* P2, const bf16_t* PWT, int item, PoolRegs& R, int tid) {
    const int gi = item & 3, r0 = (item >> 2) * 64, t0 = r0 & (SEQ - 1);
    { const int lane = tid & 63, wave = tid >> 6, fr = lane & 15, fq = lane >> 4, row = r0 + (wave & 3) * 16 + fr;
#pragma unroll
      for (int nb = 0; nb < 4; ++nb) R.zs[nb] = *(const u32x2*)(P2 + (size_t)row * P2LD + 1536 + gi * 128 + ((wave >> 2) * 4 + nb) * 16 + fq * 4); }
    const bf16_t* vb = P2 + (ptrdiff_t)(r0 - 16) * P2LD + 1024 + gi * 128;
#pragma unroll
    for (int k = 0; k < 3; ++k) { const int idx = tid + 512 * k, lrow = idx >> 4;
        const bool valid = (idx < PT_ROWS * 16) && (t0 != 0 || lrow >= 16);
        R.v[k] = (u32x4){0u, 0u, 0u, 0u};
        if (valid) R.v[k] = *(const u32x4*)(vb + (ptrdiff_t)lrow * P2LD + (idx & 15) * 8); }
    const bf16_t* wb = PWT + (size_t)gi * 16384;
#pragma unroll
    for (int k = 0; k < 4; ++k) { const int idx = tid + 512 * k; R.w[k] = *(const u32x4*)(wb + idx * 8); }
}
__device__ __forceinline__ void pool_store_lds(LAS unsigned char* buf, const PoolRegs& R, int tid) {
#pragma unroll
    for (int k = 0; k < 3; ++k) { const int idx = tid + 512 * k; if (idx < PT_ROWS * 16) *(LAS u32x4*)(buf + (idx >> 4) * PT_ROWB + (idx & 15) * 16) = R.v[k]; }
#pragma unroll
    for (int k = 0; k < 4; ++k) { const int idx = tid + 512 * k, n = idx >> 4, c16 = idx & 15, ks = c16 >> 2, cc = c16 & 3;
        LAS unsigned char* rowp = buf + PT_VBYTES + n * PT_ROWB + ks * 64 + (cc >> 1) * 8;
        *(LAS u32x2*)(rowp + ((2 * cc) & 3) * 16) = (u32x2){R.w[k].x, R.w[k].y};
        *(LAS u32x2*)(rowp + ((2 * cc + 1) & 3) * 16) = (u32x2){R.w[k].z, R.w[k].w}; }
}
__device__ __forceinline__ void pool_compute(const Params& p, LAS unsigned char* buf, const u32x2 (&zs)[4], bf16_t* YB, int item, int wave, int lane) {
    const int gi = item & 3, r0 = (item >> 2) * 64, t0 = r0 & (SEQ - 1), w = 2 << gi;
    const int fr = lane & 15, fq = lane >> 4, sb = wave & 3, nh = wave >> 2;
    const int lr = sb * 16 + fr, row = r0 + lr, t = t0 + lr;
    f32x4 sc[4];
#pragma unroll
    for (int nb = 0; nb < 4; ++nb) { const int col = gi * 128 + (nh * 4 + nb) * 16 + fq * 4; sc[nb] = *(const f32x4*)(p.pool_scale + col); }
    const int cnti = (t + 1 < w) ? (t + 1) : w;
    const float ic = 1.0f / (float)cnti;
    float bw[8];
#pragma unroll
    for (int e = 0; e < 8; ++e) { const int d = fr - (8 * fq + e - 16); bw[e] = ((d >= 0 && d < w) ? ic : 0.0f) - (d == 0 ? 1.0f : 0.0f); }
    u32x4 bo; bo.x = cvt_pk_bf16(bw[0], bw[1]); bo.y = cvt_pk_bf16(bw[2], bw[3]); bo.z = cvt_pk_bf16(bw[4], bw[5]); bo.w = cvt_pk_bf16(bw[6], bw[7]);
    const bf16x8 band = __builtin_bit_cast(bf16x8, bo);
    const unsigned tra = (unsigned)(size_t)(buf + (sb * 16 + 8 * fq + (fr >> 2)) * PT_ROWB + (fr & 3) * 8);
    f32x4 pl[8];
    u32x2 xr[16];
    asm volatile(
        "ds_read_b64_tr_b16 %0, %16\n\tds_read_b64_tr_b16 %1, %16 offset:1088\n\t"
        "ds_read_b64_tr_b16 %2, %16 offset:32\n\tds_read_b64_tr_b16 %3, %16 offset:1120\n\t"
        "ds_read_b64_tr_b16 %4, %16 offset:64\n\tds_read_b64_tr_b16 %5, %16 offset:1152\n\t"
        "ds_read_b64_tr_b16 %6, %16 offset:96\n\tds_read_b64_tr_b16 %7, %16 offset:1184\n\t"
        "ds_read_b64_tr_b16 %8, %16 offset:128\n\tds_read_b64_tr_b16 %9, %16 offset:1216\n\t"
        "ds_read_b64_tr_b16 %10, %16 offset:160\n\tds_read_b64_tr_b16 %11, %16 offset:1248\n\t"
        "ds_read_b64_tr_b16 %12, %16 offset:192\n\tds_read_b64_tr_b16 %13, %16 offset:1280\n\t"
        "ds_read_b64_tr_b16 %14, %16 offset:224\n\tds_read_b64_tr_b16 %15, %16 offset:1312\n\t"
        "s_waitcnt lgkmcnt(0)"
        : "=&v"(xr[0]), "=&v"(xr[1]), "=&v"(xr[2]), "=&v"(xr[3]), "=&v"(xr[4]), "=&v"(xr[5]), "=&v"(xr[6]), "=&v"(xr[7]),
          "=&v"(xr[8]), "=&v"(xr[9]), "=&v"(xr[10]), "=&v"(xr[11]), "=&v"(xr[12]), "=&v"(xr[13]), "=&v"(xr[14]), "=&v"(xr[15])
        : "v"(tra) : "memory");
    static_assert(4 * PT_ROWB == 1088, "transposed-read immediates assume 272-byte rows");
#pragma unroll
    for (int cbk = 0; cbk < 8; ++cbk) {
        const bf16x8 xf = __builtin_bit_cast(bf16x8, (u32x4){xr[2 * cbk].x, xr[2 * cbk].y, xr[2 * cbk + 1].x, xr[2 * cbk + 1].y});
        pl[cbk] = __builtin_amdgcn_mfma_f32_16x16x32_bf16(xf, band, (f32x4){0.f, 0.f, 0.f, 0.f}, 0, 0, 0);
    }
    bf16x8 af[4];
#pragma unroll
    for (int ks = 0; ks < 4; ++ks) {
        u32x4 o; o.x = pk_bf16_c(pl[2 * ks][0], pl[2 * ks][1]); o.y = pk_bf16_c(pl[2 * ks][2], pl[2 * ks][3]); o.z = pk_bf16_c(pl[2 * ks + 1][0], pl[2 * ks + 1][1]); o.w = pk_bf16_c(pl[2 * ks + 1][2], pl[2 * ks + 1][3]);
        af[ks] = __builtin_bit_cast(bf16x8, o);
    }
    const LAS unsigned char* wrow = buf + PT_VBYTES + fr * PT_ROWB + fq * 16;
#pragma unroll
    for (int nb = 0; nb < 4; ++nb) {
        const int nbg = nh * 4 + nb;
        f32x4 acc = (f32x4){0.f, 0.f, 0.f, 0.f};
#pragma unroll
        for (int ks = 0; ks < 4; ++ks) {
            const bf16x8 bfrag = *(const LAS bf16x8*)(wrow + nbg * 16 * PT_ROWB + ks * 64);
            acc = __builtin_amdgcn_mfma_f32_16x16x32_bf16(bfrag, af[ks], acc, 0, 0, 0);
        }
        const int col = gi * 128 + nbg * 16 + fq * 4;
        u32x2 o; o.x = cvt_pk_bf16(acc[0] * sc[nb][0] * bf_lo(zs[nb].x), acc[1] * sc[nb][1] * bf_hi(zs[nb].x)); o.y = cvt_pk_bf16(acc[2] * sc[nb][2] * bf_lo(zs[nb].y), acc[3] * sc[nb][3] * bf_hi(zs[nb].y));
        *(u32x2*)(YB + (size_t)row * DM + 512 + col) = o;
    }
}

__device__ __forceinline__ void phase_mix_prompt(const Params& p, LAS unsigned char* lds, int wi, int NW, int wave, int lane) {
    asm volatile("" : "+v"(lane), "+s"(wi), "+s"(wave));
    const bf16_t* P2 = (const bf16_t*)(p.ws + WS_P2); const bf16_t* PWT = (const bf16_t*)(p.ws + WS_PW); bf16_t* YB = (bf16_t*)(p.ws + WS_YB);
    const int tid = wave * 64 + lane;
    constexpr int NPOOL = (MP / 64) * 4, NCONV = MP / 8;
    PoolRegs Ra, Rb; int item = wi, buf = 0;
    if (item < NPOOL) pool_load(P2, PWT, item, Ra, tid);
    if (item + NW < NPOOL) pool_load(P2, PWT, item + NW, Rb, tid);
    for (; item < NPOOL; item += NW) {
        LAS unsigned char* b = lds + buf * PT_BUF;
        pool_store_lds(b, Ra, tid);
        u32x2 zc[4];
#pragma unroll
        for (int nb = 0; nb < 4; ++nb) zc[nb] = Ra.zs[nb];
        __syncthreads();
        Ra = Rb;
        if (item + 2 * NW < NPOOL) pool_load(P2, PWT, item + 2 * NW, Rb, tid);
        pool_compute(p, b, zc, YB, item, wave, lane);
        buf ^= 1;
    }
    const ConvW cw = load_convw(p, lane * 8);
    for (int it = wi * 8 + wave; it < NCONV; it += NW * 8) conv_item_prompt(P2, YB, cw, it * 8, lane * 8);
}

constexpr int SP_ROWB = 528, SP_SEQB = 19 * SP_ROWB;
struct SPre { bf16x8 bfr[4]; f32x4 sc; f32x4 sv[4]; };
__device__ __forceinline__ void pool_wg_item_sample_pre(const Params& p, const bf16_t* PWT, int item, int wave, int lane, SPre& R) {
    const int tid = wave * 64 + lane, rb = item >> 2, gi = item & 3, fr = lane & 15, fq = lane >> 4;
    const bf16_t* pw = PWT + (size_t)gi * 16384 + (size_t)(wave * 16 + fr) * 128 + fq * 8;
#pragma unroll
    for (int ks = 0; ks < 4; ++ks) R.bfr[ks] = *(const bf16x8*)(pw + ks * 32);
    R.sc = *(const f32x4*)(p.pool_scale + gi * 128 + wave * 16 + fq * 4);
#pragma unroll
    for (int k = 0; k < 4; ++k) { const int idx = tid + 512 * k; R.sv[k] = (f32x4){0.f, 0.f, 0.f, 0.f};
        if (idx < 1920) { const int s = idx / 480, rem = idx - s * 480, r = rem >> 5, c4 = rem & 31;
            R.sv[k] = *(const f32x4*)(p.spool + ((size_t)(rb * 4 + s) * 15 + r) * DPL + gi * 128 + c4 * 4); } }
}
__device__ __forceinline__ void pool_wg_item_sample(const Params& p, LAS unsigned char* lds, const bf16_t* P2, const bf16_t* PWT, bf16_t* YB, int item, int wave, int lane, bool use_pre, const SPre& pre) {
    const int tid = wave * 64 + lane, rb = item >> 2, gi = item & 3, w = 2 << gi;
    const int fr = lane & 15, fq = lane >> 4;
    const int row = MP + rb * 16 + fr, sq = fr >> 2, t = fr & 3;
    const bf16_t* pw = PWT + (size_t)gi * 16384 + (size_t)(wave * 16 + fr) * 128 + fq * 8;
    bf16x8 bfr[4];
#pragma unroll
    for (int ks = 0; ks < 4; ++ks) bfr[ks] = use_pre ? pre.bfr[ks] : *(const bf16x8*)(pw + ks * 32);
    const int col = gi * 128 + wave * 16 + fq * 4;
    const f32x4 sc = use_pre ? pre.sc : *(const f32x4*)(p.pool_scale + col);
    const u32x2 zw = *(const u32x2*)(P2 + (size_t)row * P2LD + 1536 + col);
    f32x4 sv[4]; u32x4 vv = (u32x4){0u, 0u, 0u, 0u};
#pragma unroll
    for (int k = 0; k < 4; ++k) { const int idx = tid + 512 * k; sv[k] = (f32x4){0.f, 0.f, 0.f, 0.f};
        if (use_pre) sv[k] = pre.sv[k];
        else if (idx < 1920) { const int s = idx / 480, rem = idx - s * 480, r = rem >> 5, c4 = rem & 31;
            sv[k] = *(const f32x4*)(p.spool + ((size_t)(rb * 4 + s) * 15 + r) * DPL + gi * 128 + c4 * 4); } }
    if (tid < 256) vv = *(const u32x4*)(P2 + (size_t)(MP + rb * 16 + (tid >> 4)) * P2LD + 1024 + gi * 128 + (tid & 15) * 8);
#pragma unroll
    for (int k = 0; k < 4; ++k) { const int idx = tid + 512 * k;
        if (idx < 1920) { const int s = idx / 480, rem = idx - s * 480, r = rem >> 5, c4 = rem & 31; *(LAS f32x4*)(lds + s * SP_SEQB + r * SP_ROWB + c4 * 16) = sv[k]; } }
    if (tid < 256) { const int lr = tid >> 4, s = lr >> 2, tt = lr & 3, c8 = tid & 15; const F8 f = unpack8(vv);
        LAS unsigned char* d = lds + s * SP_SEQB + (15 + tt) * SP_ROWB + c8 * 32;
        *(LAS f32x4*)d = (f32x4){f.v[0], f.v[1], f.v[2], f.v[3]}; *(LAS f32x4*)(d + 16) = (f32x4){f.v[4], f.v[5], f.v[6], f.v[7]}; }
    __syncthreads();
    const LAS unsigned char* base = lds + sq * SP_SEQB + (15 + t) * SP_ROWB + fq * 32;
    const float ic = 1.0f / (float)w;
    bf16x8 af[4];
#pragma unroll
    for (int ks = 0; ks < 4; ++ks) {
        const f32x4 a0 = *(const LAS f32x4*)(base + ks * 128), a1 = *(const LAS f32x4*)(base + ks * 128 + 16);
        f32x4 s0 = a0, s1 = a1;
#pragma unroll 4
        for (int j = 1; j < w; ++j) { s0 += *(const LAS f32x4*)(base - j * SP_ROWB + ks * 128); s1 += *(const LAS f32x4*)(base - j * SP_ROWB + ks * 128 + 16); }
        const f32x4 p0 = s0 * ic - a0, p1 = s1 * ic - a1;
        u32x4 o; o.x = cvt_pk_bf16(p0[0], p0[1]); o.y = cvt_pk_bf16(p0[2], p0[3]); o.z = cvt_pk_bf16(p1[0], p1[1]); o.w = cvt_pk_bf16(p1[2], p1[3]);
        af[ks] = __builtin_bit_cast(bf16x8, o);
    }
    f32x4 acc = (f32x4){0.f, 0.f, 0.f, 0.f};
#pragma unroll
    for (int ks = 0; ks < 4; ++ks) acc = __builtin_amdgcn_mfma_f32_16x16x32_bf16(bfr[ks], af[ks], acc, 0, 0, 0);
    u32x2 o; o.x = cvt_pk_bf16(acc[0] * sc[0] * bf_lo(zw.x), acc[1] * sc[1] * bf_hi(zw.x)); o.y = cvt_pk_bf16(acc[2] * sc[2] * bf_lo(zw.y), acc[3] * sc[3] * bf_hi(zw.y));
    st_wt8(YB + (size_t)row * DM + 512 + col, o.x, o.y);
    asm volatile("s_waitcnt vmcnt(0)" ::: "memory");
    __syncthreads();
    if (tid == 0) (void)xb_add(g_ctl + CTL_MIXS + 8 * rb, 1u);
}

__device__ __forceinline__ void phase_mix_sample_old(const Params& p, int gw, int NGW, int lane) {
    asm volatile("" : "+v"(lane), "+s"(gw));
    const bf16_t* P2 = (const bf16_t*)(p.ws + WS_P2); const bf16_t* PWT = (const bf16_t*)(p.ws + WS_PW); bf16_t* YB = (bf16_t*)(p.ws + WS_YB);
    constexpr int NPOOL = (MS / 16) * 4;
    for (int item = gw; item < NPOOL + MS; item += NGW) {
        if (item < NPOOL) pool_item_sample(p, P2, PWT, YB, MP / 16 + (item >> 2), item & 3, lane);
        else { const ConvW cw = load_convw(p, lane * 8); conv_item_sample(p, P2, YB, cw, MP + (item - NPOOL), lane * 8); }
    }
}

__device__ __forceinline__ void phase_mix_sample(const Params& p, LAS unsigned char* lds, int c, int G, int wave, int lane, bool has_pre, const SPre& pre) {
    asm volatile("" : "+v"(lane), "+s"(c), "+s"(wave));
    const bf16_t* P2 = (const bf16_t*)(p.ws + WS_P2); const bf16_t* PWT = (const bf16_t*)(p.ws + WS_PW); bf16_t* YB = (bf16_t*)(p.ws + WS_YB);
    constexpr int NPOOL = (MS / 16) * 4;
    for (int item = c; item < NPOOL; item += G) pool_wg_item_sample(p, lds, P2, PWT, YB, item, wave, lane, has_pre && item == c, pre);
    const int NW8 = G * 8; int gwv = ((c + G - (NPOOL % G)) % G) * 8 + wave;
    const ConvW cw = load_convw(p, lane * 8);
    for (int it = gwv; it < MS; it += NW8) conv_item_sample(p, P2, YB, cw, MP + it, lane * 8);
}

__device__ __forceinline__ void phase_final(const Params& p, int r_lo, int r_hi, int gw, int NGW, int lane) {
    asm volatile("" : "+v"(lane), "+s"(gw));
    f32x4 g[4];
#pragma unroll
    for (int j = 0; j < 4; ++j) g[j] = *((const f32x4*)p.final_g + lane + 64 * j);
    for (int r = r_lo + gw; r < r_hi; r += 4 * NGW) {
        f32x4 v[4][4]; f32x4* rowp[4]; bool has[4];
#pragma unroll
        for (int k = 0; k < 4; ++k) { const int rk = r + k * NGW; has[k] = rk < r_hi; rowp[k] = (f32x4*)(p.out + (size_t)(has[k] ? rk : r) * DM) + lane;
#pragma unroll
            for (int j = 0; j < 4; ++j) v[k][j] = rowp[k][64 * j]; }
#pragma unroll
        for (int k = 0; k < 4; ++k) { float s = 0.f;
#pragma unroll
            for (int j = 0; j < 4; ++j) s += (v[k][j].x * v[k][j].x + v[k][j].y * v[k][j].y) + (v[k][j].z * v[k][j].z + v[k][j].w * v[k][j].w);
            const float rinv = rsqrtf(wave_sum(s) * (1.0f / DM) + EPS);
            if (has[k]) {
#pragma unroll
                for (int j = 0; j < 4; ++j) rowp[k][64 * j] = v[k][j] * rinv * g[j]; } }
    }
}

__device__ __forceinline__ void g1s_item(const Params& p, int item, int lane) {
    const bf16_t* XN = (const bf16_t*)(p.ws + WS_XN); const bf16_t* WT = (const bf16_t*)(p.ws + WS_WIN); bf16_t* P2 = (bf16_t*)(p.ws + WS_P2);
    const int fr = lane & 15, fq = lane >> 4;
    const int rb = item / 48, cgi = item - rb * 48, pn = cgi >> 2, sub = cgi & 3;
    const int row = MP + rb * 16 + fr;
    const bf16_t* ap = XN + (size_t)row * DM + fq * 8;
    const bf16_t* bp = WT + (size_t)(pn * 256 + sub * 32 + fr) * DM + fq * 8;
    f32x4 acc[4];
#pragma unroll
    for (int i = 0; i < 4; ++i) acc[i] = (f32x4){0.f, 0.f, 0.f, 0.f};
#pragma unroll 4
    for (int ks = 0; ks < DM / 32; ++ks) {
        const bf16x8 a = *(const bf16x8*)(ap + ks * 32);
#pragma unroll
        for (int i = 0; i < 4; ++i) {
            const bf16x8 b = *(const bf16x8*)(bp + (size_t)((i >> 1) * 128 + (i & 1) * 16) * DM + ks * 32);
            acc[i] = __builtin_amdgcn_mfma_f32_16x16x32_bf16(b, a, acc[i], 0, 0, 0);
        }
    }
    const int ty = pn >> 2, q = row - MP, sb = q >> 2, st = q & 3;
#pragma unroll
    for (int nbk = 0; nbk < 2; ++nbk) {
        const int loc = (pn & 3) * 128 + sub * 32 + nbk * 16 + fq * 4;
        const f32x4 a = acc[nbk], b = acc[2 + nbk];
        bf16_t* prow = P2 + (size_t)row * P2LD + loc;
        if (ty == 0) {
            const f32x4 cu = a * b;
            u32x2 o; o.x = cvt_pk_bf16(cu[0], cu[1]); o.y = cvt_pk_bf16(cu[2], cu[3]); *(u32x2*)prow = o;
            if (st >= 2) *(f32x4*)(p.out + O_CONVS + ((size_t)sb * 2 + (st - 2)) * DC + loc) = cu;
        } else if (ty == 1) {
            u32x2 o; o.x = cvt_pk_bf16(a[0] * silu(b[0]), a[1] * silu(b[1])); o.y = cvt_pk_bf16(a[2] * silu(b[2]), a[3] * silu(b[3])); *(u32x2*)(prow + 512) = o;
        } else {
            u32x2 o; o.x = cvt_pk_bf16(a[0], a[1]); o.y = cvt_pk_bf16(a[2], a[3]); *(u32x2*)(prow + 1024) = o;
            u32x2 z; z.x = cvt_pk_bf16(silu(b[0]), silu(b[1])); z.y = cvt_pk_bf16(silu(b[2]), silu(b[3])); *(u32x2*)(prow + 1536) = z;
            *(f32x4*)(p.out + O_POOLS + ((size_t)sb * 15 + 11 + st) * DPL + loc) = a;
        }
    }
}
__device__ __forceinline__ void g2s_item(const Params& p, int item, int lane) {
    const bf16_t* YB = (const bf16_t*)(p.ws + WS_YB); const bf16_t* WT = (const bf16_t*)(p.ws + WS_WOUT);
    const int fr = lane & 15, fq = lane >> 4;
    const int rb = item >> 6, cb = item & 63;
    const int row = MP + rb * 16 + fr;
    const bf16_t* ap = YB + (size_t)row * DM + fq * 8;
    const bf16_t* bp = WT + (size_t)(cb * 16 + fr) * DM + fq * 8;
    f32x4 acc = (f32x4){0.f, 0.f, 0.f, 0.f};
#pragma unroll 16
    for (int ks = 0; ks < DM / 32; ++ks) {
        const bf16x8 a = *(const bf16x8*)(ap + ks * 32);
        const bf16x8 b = *(const bf16x8*)(bp + ks * 32);
        acc = __builtin_amdgcn_mfma_f32_16x16x32_bf16(b, a, acc, 0, 0, 0);
    }
    const size_t o = (size_t)(row - MP) * DM + cb * 16 + fq * 4;
    const f32x4 h = acc + *(const f32x4*)(p.xs + o);
    float* dst = p.out + (size_t)MP * DM + o;
    asm volatile("s_nop 1\n\tglobal_store_dwordx4 %0, %1, off sc0 sc1" :: "v"(dst), "v"(h) : "memory");
    asm volatile("s_waitcnt vmcnt(0)" ::: "memory");
    unsigned old = 0;
    if (lane == 0) old = xb_add(g_ctl + CTL_CNT + 64 * 68 + 16 * rb, 1u);
    old = __builtin_amdgcn_readfirstlane(old);
    if (old == 63u) {
        __builtin_amdgcn_fence(__ATOMIC_ACQUIRE, "agent");
        asm volatile("s_waitcnt vmcnt(0)" ::: "memory");
        f32x4 g[4];
#pragma unroll
        for (int j = 0; j < 4; ++j) g[j] = *((const f32x4*)p.final_g + lane + 64 * j);
        for (int r4 = 0; r4 < 16; r4 += 4) {
            f32x4 v[4][4];
#pragma unroll
            for (int k = 0; k < 4; ++k)
#pragma unroll
                for (int j = 0; j < 4; ++j) v[k][j] = *((const f32x4*)(p.out + (size_t)(MP + rb * 16 + r4 + k) * DM) + lane + 64 * j);
#pragma unroll
            for (int k = 0; k < 4; ++k) { float s = 0.f;
#pragma unroll
                for (int j = 0; j < 4; ++j) s += (v[k][j].x * v[k][j].x + v[k][j].y * v[k][j].y) + (v[k][j].z * v[k][j].z + v[k][j].w * v[k][j].w);
                const float rinv = rsqrtf(wave_sum(s) * (1.0f / DM) + EPS);
#pragma unroll
                for (int j = 0; j < 4; ++j) *((f32x4*)(p.out + (size_t)(MP + rb * 16 + r4 + k) * DM) + lane + 64 * j) = v[k][j] * rinv * g[j]; }
        }
    }
}

__device__ __forceinline__ void g2s_wg_item(const Params& p, LAS unsigned char* lds, int item, int wave, int lane) {
    const bf16_t* YB = (const bf16_t*)(p.ws + WS_YB); const bf16_t* WT = (const bf16_t*)(p.ws + WS_WOUT);
    const int fr = lane & 15, fq = lane >> 4;
    const int rb = item >> 3, cgp = item & 7;
    const int row = MP + rb * 16 + fr;
    const bf16_t* ap = YB + (size_t)row * DM + wave * 128 + fq * 8;
    const bf16_t* bp = WT + (size_t)(cgp * 128 + fr) * DM + wave * 128 + fq * 8;
    bf16x8 b[8][4];
#pragma unroll
    for (int nb = 0; nb < 8; ++nb)
#pragma unroll
        for (int ks = 0; ks < 4; ++ks) b[nb][ks] = *(const bf16x8*)(bp + (size_t)nb * 16 * DM + ks * 32);
    const size_t o = (size_t)(row - MP) * DM + cgp * 128 + wave * 16 + fq * 4;
    const f32x4 xres = *(const f32x4*)(p.xs + o);
    if (threadIdx.x == 0) {
        unsigned* cm = g_ctl + CTL_MIXS + 8 * rb; unsigned sp = 0;
        while (xb_ld(cm) < 20u) { __builtin_amdgcn_s_sleep(1); if ((++sp & 255u) == 0u) { if (xb_ld(g_ctl + XB_TMO)) break; if (sp > XB_SPIN_CAP) { atomicAdd(g_ctl + XB_TMO, 1u); break; } } }
        __builtin_amdgcn_fence(__ATOMIC_ACQUIRE, "agent");
        asm volatile("s_waitcnt vmcnt(0)" ::: "memory");
    }
    __syncthreads();
    bf16x8 a[4];
#pragma unroll
    for (int ks = 0; ks < 4; ++ks) a[ks] = *(const bf16x8*)(ap + ks * 32);
    f32x4 acc[8];
#pragma unroll
    for (int nb = 0; nb < 8; ++nb) { acc[nb] = (f32x4){0.f, 0.f, 0.f, 0.f};
#pragma unroll
        for (int ks = 0; ks < 4; ++ks) acc[nb] = __builtin_amdgcn_mfma_f32_16x16x32_bf16(b[nb][ks], a[ks], acc[nb], 0, 0, 0); }
#pragma unroll
    for (int nb = 0; nb < 8; ++nb) *(LAS f32x4*)(lds + ((wave * 8 + nb) * 64 + lane) * 16) = acc[nb];
    __syncthreads();
    f32x4 s = (f32x4){0.f, 0.f, 0.f, 0.f};
#pragma unroll
    for (int sw = 0; sw < 8; ++sw) s += *(const LAS f32x4*)(lds + ((sw * 8 + wave) * 64 + lane) * 16);
    const f32x4 h = s + xres;
    float* dst = p.out + (size_t)MP * DM + o;
    asm volatile("s_nop 1\n\tglobal_store_dwordx4 %0, %1, off sc0 sc1" :: "v"(dst), "v"(h) : "memory");
    asm volatile("s_waitcnt vmcnt(0)" ::: "memory");
    __syncthreads();
    volatile LAS unsigned* flag = (volatile LAS unsigned*)(lds + 65536);
    if (threadIdx.x == 0) {
        const unsigned old = xb_add(g_ctl + CTL_CNT + 64 * 68 + 16 * rb, 1u);
        if (old == 7u) { __builtin_amdgcn_fence(__ATOMIC_ACQUIRE, "agent"); asm volatile("s_waitcnt vmcnt(0)" ::: "memory"); }
        flag[0] = (old == 7u) ? 1u : 0u;
    }
    __syncthreads();
    if (flag[0]) {
        f32x4 g[4], v[2][4];
#pragma unroll
        for (int j = 0; j < 4; ++j) g[j] = *((const f32x4*)p.final_g + lane + 64 * j);
#pragma unroll
        for (int k = 0; k < 2; ++k)
#pragma unroll
            for (int j = 0; j < 4; ++j) v[k][j] = *((const f32x4*)(p.out + (size_t)(MP + rb * 16 + wave * 2 + k) * DM) + lane + 64 * j);
#pragma unroll
        for (int k = 0; k < 2; ++k) { float ss = 0.f;
#pragma unroll
            for (int j = 0; j < 4; ++j) ss += (v[k][j].x * v[k][j].x + v[k][j].y * v[k][j].y) + (v[k][j].z * v[k][j].z + v[k][j].w * v[k][j].w);
            const float rinv = rsqrtf(wave_sum(ss) * (1.0f / DM) + EPS);
#pragma unroll
            for (int j = 0; j < 4; ++j) *((f32x4*)(p.out + (size_t)(MP + rb * 16 + wave * 2 + k) * DM) + lane + 64 * j) = v[k][j] * rinv * g[j]; }
    }
    __syncthreads();
}

__device__ __forceinline__ void wg_publish(unsigned* cnt) {
    asm volatile("s_waitcnt vmcnt(0)" ::: "memory");
    __syncthreads();
    if (threadIdx.x == 0) {
        __builtin_amdgcn_fence(__ATOMIC_RELEASE, "agent");
        asm volatile("s_waitcnt vmcnt(0)" ::: "memory");
        (void)xb_add(cnt, 1u);
    }
}
__device__ __forceinline__ void wg_wait(unsigned* cnt, unsigned need, unsigned* tmo) {
    if (threadIdx.x == 0) {
        unsigned sp = 0;
        while (xb_ld(cnt) < need) { __builtin_amdgcn_s_sleep(1); if ((++sp & 255u) == 0u) { if (xb_ld(tmo)) break; if (sp > XB_SPIN_CAP) { atomicAdd(tmo, 1u); break; } } }
        __builtin_amdgcn_fence(__ATOMIC_ACQUIRE, "agent");
        asm volatile("s_waitcnt vmcnt(0)" ::: "memory");
    }
    __syncthreads();
}

constexpr int NS1 = (MS / HALF) * (DIN / BM), NS2 = 2 * (DM / BM);

__global__ void __launch_bounds__(512, 2) fwd_megakernel(Params p) {
    extern __shared__ __attribute__((aligned(16))) unsigned char shm[];
    LAS unsigned char* lds = (LAS unsigned char*)shm;
    cg::grid_group grid = cg::this_grid();
    if (p.never) grid.sync();
    volatile LAS unsigned* xst = (volatile LAS unsigned*)(lds + STAGE_BYTES);
    if (threadIdx.x == 0) { xst[0] = 0u; xst[1] = 0u; xst[2] = 0u; xst[3] = 0u; }
    __syncthreads();
    const XcdBarrier xb = xcd_barrier_post(g_ctl, xst);
    const int tid = threadIdx.x, wave = __builtin_amdgcn_readfirstlane(tid >> 6), lane = tid & 63;
    const int G = (int)gridDim.x, c = (int)blockIdx.x;
    const int gw = c * 8 + wave, NGW = G * 8;

    phase_prep(p, lds, gw, NGW, wave, lane);
    xcd_barrier(xb);
    { const Gemm g{(const bf16_t*)(p.ws + WS_XN), (const bf16_t*)(p.ws + WS_WIN), MT, DIN, DM};
      { const EpiMix E{(bf16_t*)(p.ws + WS_P2), p.out, 2};
        Order S; S.init(MP / BM, DIN / BM, 0, G, c);
        gemm_phase(lds, g, S, E); }
      xcd_barrier(xb);
      { const EpiMix E{(bf16_t*)(p.ws + WS_P2), p.out, 1};
        Order S; S.init(MS / HALF, DIN / BM, 0, G, c, MP, HALF);
        gemm_phase<EpiMix, Order, true>(lds, g, S, E); }
      if (c >= NS1) { phase_mix_prompt(p, lds, c - NS1, G - NS1, wave, lane); __syncthreads(); phase_late_prep(p, lds, (c - NS1) * 8 + wave, (G - NS1) * 8, wave, lane); }
      xcd_barrier(xb, true);
    }
    SPre spre; const bool has_pre = c < (MS / 16) * 4;
    if (has_pre) pool_wg_item_sample_pre(p, (const bf16_t*)(p.ws + WS_PW), c, wave, lane, spre);
    xcd_barrier_finish(xb);
    phase_mix_sample(p, lds, c, G, wave, lane, has_pre, spre);
    __syncthreads();
    { int cs = c, ws_ = wave; asm volatile("" : "+s"(cs), "+s"(ws_)); int ln = lane; asm volatile("" : "+v"(ln));
      for (int item = cs; item < (MS / 16) * 8; item += G) g2s_wg_item(p, lds, item, ws_, ln); }
    { const Gemm g{(const bf16_t*)(p.ws + WS_YB), (const bf16_t*)(p.ws + WS_WOUT), MT, DM, DM};
      const EpiOutNorm E{p.out, p.xp, p.final_g, (float*)(p.ws + WS_STATS), g_ctl + CTL_CNT, g_ctl + XB_TMO};
      Order S; S.init(MP / BM, DM / BM, 0, G, c);
      gemm_phase(lds, g, S, E); }
    __syncthreads();
    if (threadIdx.x == 0) { const unsigned old = xb_add(g_ctl + CTL_EXIT, 1u); xst[0] = (old == (unsigned)G - 1u) ? 1u : 0u; }
    __syncthreads();
    if (xst[0]) { for (int i = threadIdx.x; i < CTL_WORDS; i += 512) g_ctl[i] = 0u; }
}

extern "C" void kernel_launch(void* const* d_in, const int* in_sizes, int n_in, void* d_out, int out_size, void* d_ws, size_t ws_size, hipStream_t stream) {
    static int grid_blocks = 0;
    if (!grid_blocks) {
        int dev = 0, cus = 0, per_cu = 0;
        (void)hipGetDevice(&dev);
        (void)hipDeviceGetAttribute(&cus, hipDeviceAttributeMultiprocessorCount, dev);
        if (hipFuncSetAttribute((const void*)fwd_megakernel, hipFuncAttributeMaxDynamicSharedMemorySize, LDS_BYTES) != hipSuccess) fprintf(stderr, "hipFuncSetAttribute failed\n");
        (void)hipOccupancyMaxActiveBlocksPerMultiprocessor(&per_cu, (const void*)fwd_megakernel, 512, LDS_BYTES);
        if (per_cu < 1) { fprintf(stderr, "occupancy query says %d blocks/CU\n", per_cu); per_cu = 1; }
        grid_blocks = cus * per_cu;
        if (grid_blocks != 256) fprintf(stderr, "this kernel is built for 256 workgroups (one per CU of a 256-CU device); got %d\n", grid_blocks);
        (void)hipGetLastError();
    }
    Params p{};
    p.xp = (const float*)d_in[0]; p.xs = (const float*)d_in[1]; p.sconv = (const float*)d_in[2]; p.spool = (const float*)d_in[3];
    p.norm_g = (const float*)d_in[4]; p.w_in = (const float*)d_in[5]; p.conv_w = (const float*)d_in[6]; p.pool_w = (const float*)d_in[7];
    p.pool_scale = (const float*)d_in[8]; p.w_out = (const float*)d_in[9]; p.final_g = (const float*)d_in[10];
    p.out = (float*)d_out; p.ws = (unsigned char*)d_ws;
    void* args[] = {&p};
    hipError_t e = hipLaunchCooperativeKernel((void*)fwd_megakernel, dim3(grid_blocks), dim3(512), args, LDS_BYTES, stream);
    if (e != hipSuccess) fprintf(stderr, "cooperative launch failed: %s (grid %d)\n", hipGetErrorString(e), grid_blocks);
}
```

```cpp
#include <hip/hip_runtime.h>
#include <hip/hip_cooperative_groups.h>
#include <cstdio>
namespace cg = cooperative_groups;

#define LAS __attribute__((address_space(3)))
typedef unsigned short bf16_t;
typedef short bf16x8 __attribute__((ext_vector_type(8)));
typedef float f32x4 __attribute__((ext_vector_type(4)));
typedef unsigned u32x4 __attribute__((ext_vector_type(4)));
typedef unsigned u32x2 __attribute__((ext_vector_type(2)));

constexpr int MP = 16384, MS = 512, MT = MP + MS, DM = 1024, DIN = 3072, DC = 512, DPL = 512;
constexpr int SEQ = 2048, DSEQ = 4;
constexpr float EPS = 1e-6f;
constexpr int BM = 256, BK = 64, HALF = 128, HTB = HALF * BK * 2, STAGE_BYTES = 8 * HTB, NXCD = 8, WGM = 8;
constexpr int LDS_BYTES = STAGE_BYTES + 16;

constexpr size_t WS_BAR = 0;
constexpr size_t WS_CNT = 16384;
constexpr size_t WS_CTL_BYTES = 36864;
constexpr size_t WS_XN = WS_CTL_BYTES;
constexpr size_t WS_WIN = WS_XN + (size_t)MT * DM * 2;
constexpr size_t WS_WOUT = WS_WIN + (size_t)DIN * DM * 2;
constexpr size_t WS_PW = WS_WOUT + (size_t)DM * DM * 2;
constexpr size_t WS_P2 = WS_PW + (size_t)4 * 128 * 128 * 2;
constexpr size_t WS_YB = WS_XN;
constexpr size_t WS_STATS = WS_P2 + (size_t)MT * 2048 * 2;
constexpr size_t WS_END = WS_STATS + (size_t)64 * 4 * 256 * 4;
constexpr int P2LD = 2048;

constexpr size_t O_Y = 0;
constexpr size_t O_CONVP = (size_t)MT * DM;
constexpr size_t O_POOLP = O_CONVP + 8 * 2 * 512;
constexpr size_t O_CONVS = O_POOLP + 8 * 15 * 512;
constexpr size_t O_POOLS = O_CONVS + 128 * 2 * 512;

constexpr int CTL_WORDS = 10240, CTL_CNT = 4096, CTL_EXIT = 10000, CTL_MIXS = CTL_CNT + 64 * 68 + 512;
__device__ unsigned g_ctl[CTL_WORDS];

struct Params {
    const float *xp, *xs, *sconv, *spool, *norm_g, *w_in, *conv_w, *pool_w, *pool_scale, *w_out, *final_g;
    float* out;
    unsigned char* ws;
    unsigned long long never;
};

typedef __bf16 bf16v2_t __attribute__((ext_vector_type(2)));
typedef float f32v2_t __attribute__((ext_vector_type(2)));
__device__ __forceinline__ unsigned cvt_pk_bf16(float lo, float hi) { const bf16v2_t r = __builtin_convertvector((f32v2_t){lo, hi}, bf16v2_t); return __builtin_bit_cast(unsigned, r); }
__device__ __forceinline__ unsigned pk_bf16_c(float lo, float hi) { return cvt_pk_bf16(lo, hi); }
__device__ __forceinline__ float bf_lo(unsigned w) { return __uint_as_float(w << 16); }
__device__ __forceinline__ float bf_hi(unsigned w) { return __uint_as_float(w & 0xffff0000u); }
__device__ __forceinline__ float wave_sum(float v) {
#pragma unroll
    for (int o = 1; o < 64; o <<= 1) v += __shfl_xor(v, o);
    return v;
}
__device__ __forceinline__ float silu(float z) { return z * __builtin_amdgcn_rcpf(1.0f + __builtin_amdgcn_exp2f(-1.4426950409f * z)); }

__device__ __forceinline__ void st_wt8(void* p, unsigned lo, unsigned hi) { __hip_atomic_store((unsigned long long*)p, ((unsigned long long)hi << 32) | lo, __ATOMIC_RELAXED, __HIP_MEMORY_SCOPE_AGENT); }
struct F8 { float v[8]; };
__device__ __forceinline__ F8 ld_bf8(const bf16_t* p) {
    const u32x4 w = *(const u32x4*)p; F8 r;
    r.v[0] = bf_lo(w.x); r.v[1] = bf_hi(w.x); r.v[2] = bf_lo(w.y); r.v[3] = bf_hi(w.y);
    r.v[4] = bf_lo(w.z); r.v[5] = bf_hi(w.z); r.v[6] = bf_lo(w.w); r.v[7] = bf_hi(w.w); return r;
}
__device__ __forceinline__ F8 ld_f8(const float* p) {
    const f32x4 a = *(const f32x4*)p, b = *(const f32x4*)(p + 4); F8 r;
    r.v[0] = a.x; r.v[1] = a.y; r.v[2] = a.z; r.v[3] = a.w; r.v[4] = b.x; r.v[5] = b.y; r.v[6] = b.z; r.v[7] = b.w; return r;
}
__device__ __forceinline__ void st_f8(float* p, const F8& r) {
    *(f32x4*)p = (f32x4){r.v[0], r.v[1], r.v[2], r.v[3]}; *(f32x4*)(p + 4) = (f32x4){r.v[4], r.v[5], r.v[6], r.v[7]};
}
__device__ __forceinline__ void st_bf8(bf16_t* p, const F8& r) {
    u32x4 w; w.x = cvt_pk_bf16(r.v[0], r.v[1]); w.y = cvt_pk_bf16(r.v[2], r.v[3]); w.z = cvt_pk_bf16(r.v[4], r.v[5]); w.w = cvt_pk_bf16(r.v[6], r.v[7]);
    *(u32x4*)p = w;
}


#define XB_TMO      128
#define XB_XCNT(j)  (256  + 64 * (j))
#define XB_XSUB(j)  (1280 + 64 * (j))
#define XB_XGEN(j)  (2304 + 64 * (j))
#define XB_TOP      3328
#define XB_TOPGEN   3392
#define XCD_BAR_WORDS 3456
#define XB_SPIN_CAP (1u << 18)
__device__ __forceinline__ unsigned xb_ld(unsigned* p)              { return __hip_atomic_load(p, __ATOMIC_RELAXED, __HIP_MEMORY_SCOPE_AGENT); }
__device__ __forceinline__ unsigned xb_add(unsigned* p, unsigned v) { return __hip_atomic_fetch_add(p, v, __ATOMIC_RELAXED, __HIP_MEMORY_SCOPE_AGENT); }
__device__ __forceinline__ unsigned xb_xcc_id() { return (unsigned)__builtin_amdgcn_s_getreg((3 << 11) | 20) & 0xFu; }
#define XB_SPIN(cond, bar) do { unsigned _sp = 0; while (cond) { __builtin_amdgcn_s_sleep(1); \
    if ((++_sp & 255u) == 0u) { if (xb_ld(&(bar)[XB_TMO])) break; if (_sp > XB_SPIN_CAP) { atomicAdd(&(bar)[XB_TMO], 1u); break; } } } } while (0)
struct XcdBarrier { unsigned* bar; unsigned x; volatile LAS unsigned* st; };
__device__ __forceinline__ XcdBarrier xcd_barrier_post(unsigned* bar, volatile LAS unsigned* st) {
    XcdBarrier b; b.bar = bar; b.x = xb_xcc_id(); b.st = st;
    if (threadIdx.x == 0) (void)xb_add(&bar[XB_XCNT(b.x)], 1u);
    return b;
}
__device__ __forceinline__ void xcd_barrier_complete(unsigned* bar, unsigned x, unsigned& nloc, unsigned& nx) {
    const unsigned G = gridDim.x * gridDim.y * gridDim.z;
    unsigned sum, cnt, mine, sp = 0u;
    for (;;) {
        sum = 0u; cnt = 0u; mine = 0u;
#pragma unroll
        for (unsigned j = 0; j < 16; ++j) { const unsigned c = xb_ld(&bar[XB_XCNT(j)]); sum += c; cnt += (c > 0u) ? 1u : 0u; mine = (j == x) ? c : mine; }
        if (sum == G) break;
        __builtin_amdgcn_s_sleep(1);
        if ((++sp & 255u) == 0u) { if (xb_ld(&bar[XB_TMO])) break; if (sp > XB_SPIN_CAP) { atomicAdd(&bar[XB_TMO], 1u); break; } }
    }
    nloc = mine > 0u ? mine : 1u; nx = cnt > 0u ? cnt : 1u;
}
__device__ __forceinline__ void xcd_barrier(const XcdBarrier& b, bool defer = false) {
    asm volatile("s_waitcnt vmcnt(0)" ::: "memory");
    __syncthreads();
    if (threadIdx.x == 0) {
        unsigned* bar = b.bar;
        unsigned bx = b.x;
        asm volatile("" : "+s"(bar), "+s"(bx));
        __builtin_amdgcn_s_waitcnt(0);
        unsigned nloc = b.st[0], nx = b.st[1];
        if (nloc == 0u) { xcd_barrier_complete(bar, bx, nloc, nx); b.st[0] = nloc; b.st[1] = nx; }
        const unsigned old = xb_add(&bar[XB_XSUB(bx)], 1u);
        const unsigned gen = old / nloc;
        if (old + 1u == (gen + 1u) * nloc) {
            __builtin_amdgcn_fence(__ATOMIC_RELEASE, "agent");
            asm volatile("s_waitcnt vmcnt(0)" ::: "memory");
            const unsigned og = xb_add(&bar[XB_TOP], 1u);
            const unsigned tg = og / nx;
            if (og + 1u == (tg + 1u) * nx) xb_add(&bar[XB_TOPGEN], 1u);
            else XB_SPIN(xb_ld(&bar[XB_TOPGEN]) == tg, bar);
            __builtin_amdgcn_fence(__ATOMIC_ACQUIRE, "agent");
            xb_add(&bar[XB_XGEN(bx)], 1u);
            asm volatile("s_waitcnt vmcnt(0)" ::: "memory");
        } else if (defer) {
            b.st[2] = gen; b.st[3] = 1u;
        } else {
            XB_SPIN(xb_ld(&bar[XB_XGEN(bx)]) == gen, bar);
            __builtin_amdgcn_fence(__ATOMIC_ACQUIRE, "agent");
            asm volatile("s_waitcnt vmcnt(0)" ::: "memory");
        }
    }
    __syncthreads();
}
__device__ __forceinline__ void xcd_barrier_finish(const XcdBarrier& b) {
    __syncthreads();
    if (threadIdx.x == 0 && b.st[3] != 0u) {
        unsigned* bar = b.bar; unsigned bx = b.x;
        asm volatile("" : "+s"(bar), "+s"(bx));
        const unsigned gen = b.st[2];
        XB_SPIN(xb_ld(&bar[XB_XGEN(bx)]) == gen, bar);
        __builtin_amdgcn_fence(__ATOMIC_ACQUIRE, "agent");
        asm volatile("s_waitcnt vmcnt(0)" ::: "memory");
        b.st[3] = 0u;
    }
    __syncthreads();
}

__host__ __device__ __forceinline__ int lds_byte(int r, int c) { const int st = (r >> 4) * 2 + (c >> 5), rr = r & 15, cc = c & 31, ob = rr * 64 + cc * 2; return st * 1024 + (ob ^ (((ob >> 9) & 1) << 5)); }
__host__ __device__ __forceinline__ void stage_rc(int b, int& R, int& C) { const int st = b / 1024, sb = b % 1024, swz = sb ^ (((sb >> 9) & 1) << 5); R = (st >> 1) * 16 + swz / 64; C = (st & 1) * 32 + (swz % 64) / 2; }
__host__ __device__ __forceinline__ int perm32(int rho) { const int n = rho >> 4, i = rho & 15; return 8 * (i >> 2) + 4 * n + (i & 3); }

struct Unit { int pm, pn, row0; };
struct Gemm { const bf16_t* A; const bf16_t* Bt; int M, N, K; };

struct Order {
    int nM, nN, nwg, G, c, pm0, rbase, rstep;
    __device__ void init(int nM_, int nN_, int pm0_, int G_, int c_, int rbase_ = 0, int rstep_ = BM) { nM = nM_; nN = nN_; nwg = nM * nN; G = G_; c = c_; pm0 = pm0_; rbase = rbase_; rstep = rstep_; }
    __device__ bool next(int i, Unit& u) const {
        const long L = (long)i * G + c; if (L >= nwg) return false;
        int wgid = (int)L; { const int q = nwg / NXCD, r = nwg % NXCD, xcd = wgid % NXCD, off = wgid / NXCD; wgid = (xcd < r ? xcd * (q + 1) : r * (q + 1) + (xcd - r) * q) + off; }
        const int nig = WGM * nN, gid = wgid / nig, fm = gid * WGM, gsz = (nM - fm) < WGM ? (nM - fm) : WGM;
        const int tr = fm + ((wgid % nig) % gsz); u.pm = pm0 + tr; u.pn = (wgid % nig) / gsz; u.row0 = rbase + rstep * tr; return true;
    }
};

struct EpiMix {
    static constexpr bool PERM = true, AFTER_DRAIN = false;
    bf16_t* P2; float* out; int nai;
    __device__ __forceinline__ void operator()(const f32x4 (&acc)[2][2][4][2], const Unit& u, int wr, int wc, int fr, int fq) const {
        const int ty = u.pn >> 2, loc = (u.pn & 3) * 128 + wc * 32 + 8 * fq;
        const int rowt = u.row0 + wr * 64 + fr;
#pragma unroll
        for (int ai = 0; ai < 2; ++ai) if (ai < nai)
#pragma unroll
            for (int m = 0; m < 4; ++m) {
                const int row = rowt + ai * HALF + m * 16;
                bf16_t* prow = P2 + (size_t)row * P2LD + loc;
                F8 a, b;
#pragma unroll
                for (int i = 0; i < 4; ++i) { a.v[i] = acc[ai][0][m][0][i]; a.v[4 + i] = acc[ai][0][m][1][i]; b.v[i] = acc[ai][1][m][0][i]; b.v[4 + i] = acc[ai][1][m][1][i]; }
                int sb, st; bool samp = row >= MP;
                if (!samp) { sb = row >> 11; st = row & (SEQ - 1); } else { const int q = row - MP; sb = q >> 2; st = q & 3; }
                if (ty == 0) {
                    F8 cu;
#pragma unroll
                    for (int i = 0; i < 8; ++i) cu.v[i] = a.v[i] * b.v[i];
                    st_bf8(prow, cu);
                    if (!samp) { if (st >= SEQ - 2) st_f8(out + O_CONVP + ((size_t)sb * 2 + (st - (SEQ - 2))) * DC + loc, cu); }
                    else if (st >= 2) st_f8(out + O_CONVS + ((size_t)sb * 2 + (st - 2)) * DC + loc, cu);
                } else if (ty == 1) {
                    F8 bs;
#pragma unroll
                    for (int i = 0; i < 8; ++i) bs.v[i] = a.v[i] * silu(b.v[i]);
                    st_bf8(prow + 512, bs);
                } else {
                    F8 zs;
#pragma unroll
                    for (int i = 0; i < 8; ++i) zs.v[i] = silu(b.v[i]);
                    st_bf8(prow + 1024, a); st_bf8(prow + 1536, zs);
                    if (!samp) { if (st >= SEQ - 15) st_f8(out + O_POOLP + ((size_t)sb * 15 + (st - (SEQ - 15))) * DPL + loc, a); }
                    else st_f8(out + O_POOLS + ((size_t)sb * 15 + 11 + st) * DPL + loc, a);
                }
            }
    }
};
struct EpiOut {
    static constexpr bool PERM = false, AFTER_DRAIN = false;
    float* out; const float* xp; const float* xs;
    __device__ __forceinline__ void operator()(const f32x4 (&acc)[2][2][4][2], const Unit& u, int wr, int wc, int fr, int fq) const {
        const int row0 = u.row0 + wr * 64 + fr, col0 = u.pn * BM + wc * 32 + 4 * fq;
        const float* xbase = (u.row0 < MP) ? xp : (xs - (size_t)MP * DM);
#pragma unroll
        for (int ai = 0; ai < 2; ++ai)
#pragma unroll
            for (int m = 0; m < 4; ++m) { const size_t ro = (size_t)(row0 + ai * HALF + m * 16) * DM + col0; float* rowp = out + ro; const float* xr = xbase + ro;
#pragma unroll
                for (int bj = 0; bj < 2; ++bj)
#pragma unroll
                    for (int n = 0; n < 2; ++n) *(f32x4*)(rowp + bj * HALF + n * 16) = acc[ai][bj][m][n] + *(const f32x4*)(xr + bj * HALF + n * 16); }
    }
};

struct EpiOutNorm {
    static constexpr bool PERM = false, AFTER_DRAIN = true;
    float* out; const float* xp; const float* fg; float* stats; unsigned* cnt; unsigned* tmo;
    __device__ __forceinline__ void operator()(const f32x4 (&)[2][2][4][2], const Unit&, int, int, int, int) const {}
    __device__ __forceinline__ void fused(f32x4 (&acc)[2][2][4][2], const Unit& u, int wr, int wc, int fr, int fq, LAS unsigned char* lds, int tid) const {
        LAS float* P = (LAS float*)lds;
        LAS float* Sv = (LAS float*)(lds + 4096);
        const int rl0 = wr * 64 + fr, col0 = u.pn * BM + wc * 32 + 4 * fq;
        const size_t rbase = (size_t)(u.row0 + rl0) * DM + col0;
        f32x4 gv[2][2];
#pragma unroll
        for (int bj = 0; bj < 2; ++bj)
#pragma unroll
            for (int n = 0; n < 2; ++n) gv[bj][n] = *(const f32x4*)(fg + col0 + bj * HALF + n * 16);
#pragma unroll
        for (int ai = 0; ai < 2; ++ai) {
            f32x4 xv[4][2][2];
#pragma unroll
            for (int m = 0; m < 4; ++m) { const float* xr = xp + rbase + (size_t)(ai * HALF + m * 16) * DM;
#pragma unroll
                for (int bj = 0; bj < 2; ++bj)
#pragma unroll
                    for (int n = 0; n < 2; ++n) xv[m][bj][n] = __builtin_nontemporal_load((const f32x4*)(xr + bj * HALF + n * 16)); }
#pragma unroll
            for (int m = 0; m < 4; ++m) { float s = 0.f;
#pragma unroll
                for (int bj = 0; bj < 2; ++bj)
#pragma unroll
                    for (int n = 0; n < 2; ++n) { const f32x4 h = acc[ai][bj][m][n] + xv[m][bj][n]; acc[ai][bj][m][n] = h; s += (h[0] * h[0] + h[1] * h[1]) + (h[2] * h[2] + h[3] * h[3]); }
                s += __shfl_xor(s, 16); s += __shfl_xor(s, 32);
                if (fq == 0) P[(ai * HALF + rl0 + m * 16) * 4 + wc] = s; }
        }
        asm volatile("s_waitcnt lgkmcnt(0)" ::: "memory"); __builtin_amdgcn_s_barrier(); asm volatile("" ::: "memory");
        float* slot = stats + (size_t)(u.pm * 4) * 256;
        if (tid < 256) { const float tot = (P[tid * 4 + 0] + P[tid * 4 + 1]) + (P[tid * 4 + 2] + P[tid * 4 + 3]);
            __hip_atomic_store(slot + u.pn * 256 + tid, tot, __ATOMIC_RELAXED, __HIP_MEMORY_SCOPE_AGENT); }
        asm volatile("s_waitcnt vmcnt(0)" ::: "memory"); __builtin_amdgcn_s_barrier(); asm volatile("" ::: "memory");
        if (tid == 0) {
            unsigned* c = cnt + 64 * u.pm;
            (void)xb_add(c, 1u);
            unsigned sp = 0;
            while (xb_ld(c) < 4u) { __builtin_amdgcn_s_sleep(1); if ((++sp & 255u) == 0u) { if (xb_ld(tmo)) break; if (sp > XB_SPIN_CAP) { atomicAdd(tmo, 1u); break; } } }
        }
        asm volatile("" ::: "memory"); __builtin_amdgcn_s_barrier(); asm volatile("" ::: "memory");
        if (tid < 256) { float tot = 0.f;
#pragma unroll
            for (int q = 0; q < 4; ++q) tot += __hip_atomic_load(slot + q * 256 + tid, __ATOMIC_RELAXED, __HIP_MEMORY_SCOPE_AGENT);
            Sv[tid] = rsqrtf(tot * (1.0f / DM) + EPS); }
        asm volatile("s_waitcnt lgkmcnt(0)" ::: "memory"); __builtin_amdgcn_s_barrier(); asm volatile("" ::: "memory");
#pragma unroll
        for (int ai = 0; ai < 2; ++ai)
#pragma unroll
            for (int m = 0; m < 4; ++m) {
                const float r = Sv[ai * HALF + rl0 + m * 16];
                float* orow = out + rbase + (size_t)(ai * HALF + m * 16) * DM;
#pragma unroll
                for (int bj = 0; bj < 2; ++bj)
#pragma unroll
                    for (int n = 0; n < 2; ++n) *(f32x4*)(orow + bj * HALF + n * 16) = acc[ai][bj][m][n] * r * gv[bj][n];
            }
    }
};

template <class Epi, class Sched, bool HALFM = false>
__device__ __forceinline__ void gemm_phase(LAS unsigned char* lds, const Gemm g, const Sched& S, const Epi& E) {
    const int tid = threadIdx.x, wid = __builtin_amdgcn_readfirstlane(tid >> 6), lane = tid & 63, wr = wid >> 2, wc = wid & 3, fr = lane & 15, fq = lane >> 4;
    const int K = g.K, nt = K / BK;
    unsigned voffA[2], voffB[2];
#pragma unroll
    for (int i = 0; i < 2; ++i) { int R, C; stage_rc(tid * 16 + i * 8192, R, C); const int Rb = Epi::PERM ? ((R & ~31) + perm32(R & 31)) : R;
        voffA[i] = (unsigned)(R * K + C) * 2u; voffB[i] = (unsigned)(Rb * K + C) * 2u; }
    const size_t kstep = (size_t)(BK * 2);
    const size_t hstep = (size_t)HALF * K * 2;
    const size_t tstep = 2 * hstep;
    const unsigned ldsw = (unsigned)wid * 1024u;
    const int aoff = lds_byte(wr * 64 + fr, fq * 8), boff = lds_byte(wc * 32 + fr, fq * 8);
#define PG8_SA(b, h) (((b) * 2 + (h)) * HTB)
#define PG8_SB(b, h) ((4 + (b) * 2 + (h)) * HTB)
#define PG8_STAGE(bufoff, gbase, voff) do { _Pragma("unroll") for (int _i = 0; _i < 2; ++_i) \
        __builtin_amdgcn_global_load_lds((const unsigned*)((const char*)(gbase) + (voff)[_i]), (LAS unsigned*)(lds + (bufoff) + ldsw + _i * 8192), 16, 0, 0); } while (0)
#define PG8_LDA(dst, b, h) do { _Pragma("unroll") for (int m = 0; m < 4; ++m) _Pragma("unroll") for (int k = 0; k < 2; ++k) dst[m][k] = *(const LAS bf16x8*)(lds + PG8_SA(b, h) + aoff + m * 2048 + k * 1024); } while (0)
#define PG8_LDB(dst, b, h) do { _Pragma("unroll") for (int n = 0; n < 2; ++n) _Pragma("unroll") for (int k = 0; k < 2; ++k) dst[n][k] = *(const LAS bf16x8*)(lds + PG8_SB(b, h) + boff + n * 2048 + k * 1024); } while (0)
#define PG8_MMA(ai, bj, At, Bt) do { __builtin_amdgcn_s_setprio(1); _Pragma("unroll") for (int m = 0; m < 4; ++m) _Pragma("unroll") for (int n = 0; n < 2; ++n) _Pragma("unroll") for (int k = 0; k < 2; ++k) \
        acc[ai][bj][m][n] = __builtin_amdgcn_mfma_f32_16x16x32_bf16(Bt[n][k], At[m][k], acc[ai][bj][m][n], 0, 0, 0); __builtin_amdgcn_s_setprio(0); } while (0)
#define PG8_WAIT_V(n) asm volatile("s_waitcnt vmcnt(" #n ")" ::: "memory")
#define PG8_WAIT_L(n) asm volatile("s_waitcnt lgkmcnt(" #n ")" ::: "memory")
#define PG8_BAR __builtin_amdgcn_s_barrier()
#define PG8_SCHED __builtin_amdgcn_sched_barrier(0)
    Unit cur, nxt; int ui = 0;
    if (!S.next(0, cur)) return;
    f32x4 acc[2][2][4][2];
#pragma unroll
    for (int a = 0; a < 2; ++a)
#pragma unroll
        for (int b = 0; b < 2; ++b)
#pragma unroll
            for (int m = 0; m < 4; ++m)
#pragma unroll
                for (int n = 0; n < 2; ++n) acc[a][b][m][n] = (f32x4){0.f, 0.f, 0.f, 0.f};
    bf16x8 At[4][2], B0[2][2], B1[2][2];
    const size_t rowb = (size_t)K * 2;
    const char* cA = (const char*)g.A + (size_t)cur.row0 * rowb; const char* cB = (const char*)g.Bt + (size_t)cur.pn * tstep;
    PG8_STAGE(PG8_SB(0, 0), cB, voffB); PG8_STAGE(PG8_SA(0, 0), cA, voffA); PG8_STAGE(PG8_SB(0, 1), cB + hstep, voffB); PG8_STAGE(PG8_SA(0, 1), cA + hstep, voffA);
    if (wr == 1) PG8_BAR;
    PG8_WAIT_V(4); PG8_BAR;
    PG8_STAGE(PG8_SB(1, 0), cB + kstep, voffB); PG8_STAGE(PG8_SA(1, 0), cA + kstep, voffA); PG8_STAGE(PG8_SB(1, 1), cB + hstep + kstep, voffB);
    PG8_WAIT_V(6); PG8_BAR;
    for (;;) {
        const bool has_next = S.next(ui + 1, nxt);
        const char* nA = has_next ? (const char*)g.A + (size_t)nxt.row0 * rowb : cA; const char* nB = has_next ? (const char*)g.Bt + (size_t)nxt.pn * tstep : cB;
        for (int t = 0; t < nt; t += 2) {
            const bool last = (t == nt - 2);
            const char* a1 = cA + (size_t)(t + 1) * kstep;
            const char* a2 = last ? nA : cA + (size_t)(t + 2) * kstep; const char* b2 = last ? nB : cB + (size_t)(t + 2) * kstep;
            const char* a3 = a2 + kstep; const char* b3 = b2 + kstep;
            PG8_LDB(B0, 0, 0); PG8_SCHED; PG8_LDA(At, 0, 0); PG8_STAGE(PG8_SA(1, 1), a1 + hstep, voffA);
            PG8_WAIT_L(8); PG8_BAR; PG8_WAIT_L(0); PG8_MMA(0, 0, At, B0); PG8_BAR; PG8_SCHED;
            PG8_LDB(B1, 0, 1); PG8_STAGE(PG8_SB(0, 0), b2, voffB);
            PG8_BAR; PG8_WAIT_L(0); PG8_MMA(0, 1, At, B1); PG8_BAR;
            if (!HALFM) PG8_LDA(At, 0, 1); PG8_STAGE(PG8_SA(0, 0), a2, voffA);
            PG8_BAR; PG8_WAIT_L(0); if (!HALFM) PG8_MMA(1, 0, At, B0); PG8_BAR; PG8_SCHED;
            PG8_STAGE(PG8_SB(0, 1), b2 + hstep, voffB);
            PG8_WAIT_V(6); PG8_BAR; if (!HALFM) PG8_MMA(1, 1, At, B1); PG8_BAR;
            PG8_LDB(B0, 1, 0); PG8_SCHED; PG8_LDA(At, 1, 0); PG8_STAGE(PG8_SA(0, 1), a2 + hstep, voffA);
            PG8_WAIT_L(8); PG8_BAR; PG8_WAIT_L(0); PG8_MMA(0, 0, At, B0); PG8_BAR; PG8_SCHED;
            PG8_LDB(B1, 1, 1); PG8_STAGE(PG8_SB(1, 0), b3, voffB);
            PG8_BAR; PG8_WAIT_L(0); PG8_MMA(0, 1, At, B1); PG8_BAR;
            if (!HALFM) PG8_LDA(At, 1, 1); PG8_STAGE(PG8_SA(1, 0), a3, voffA);
            PG8_BAR; PG8_WAIT_L(0); if (!HALFM) PG8_MMA(1, 0, At, B0); PG8_BAR; PG8_SCHED;
            PG8_STAGE(PG8_SB(1, 1), b3 + hstep, voffB);
            PG8_WAIT_V(6); PG8_BAR; if (!HALFM) PG8_MMA(1, 1, At, B1); PG8_BAR;
        }
        if constexpr (!Epi::AFTER_DRAIN) E(acc, cur, wr, wc, fr, fq);
        if (!has_next) break;
#pragma unroll
        for (int a = 0; a < 2; ++a)
#pragma unroll
            for (int b = 0; b < 2; ++b)
#pragma unroll
                for (int m = 0; m < 4; ++m)
#pragma unroll
                    for (int n = 0; n < 2; ++n) acc[a][b][m][n] = (f32x4){0.f, 0.f, 0.f, 0.f};
        cur = nxt; cA = nA; cB = nB; ++ui;
    }
    PG8_WAIT_V(0);
    if (wr == 0) PG8_BAR;
    PG8_BAR;
    if constexpr (Epi::AFTER_DRAIN) E.fused(acc, cur, wr, wc, fr, fq, lds, tid);
#undef PG8_SA
#undef PG8_SB
#undef PG8_STAGE
#undef PG8_LDA
#undef PG8_LDB
#undef PG8_MMA
#undef PG8_WAIT_V
#undef PG8_WAIT_L
#undef PG8_BAR
#undef PG8_SCHED
}

__device__ __forceinline__ void p0_transpose_item(const float* W, int K, int N, bf16_t* WT, LAS float* scr, int k0, int nsrc0, int ndst0, int lane) {
    float wv[32];
#pragma unroll
    for (int i = 0; i < 32; ++i) wv[i] = __builtin_nontemporal_load(W + (size_t)(k0 + 2 * i + (lane >> 5)) * N + nsrc0 + (lane & 31));
#pragma unroll
    for (int i = 0; i < 32; ++i) scr[(2 * i + (lane >> 5)) * 33 + (lane & 31)] = wv[i];
    asm volatile("s_waitcnt lgkmcnt(0)" ::: "memory");
    const int c = lane & 7;
#pragma unroll
    for (int j = 0; j < 4; ++j) { const int n = (lane >> 3) + 8 * j; const LAS float* s = scr + (8 * c) * 33 + n;
        u32x4 o; o.x = cvt_pk_bf16(s[0 * 33], s[1 * 33]); o.y = cvt_pk_bf16(s[2 * 33], s[3 * 33]); o.z = cvt_pk_bf16(s[4 * 33], s[5 * 33]); o.w = cvt_pk_bf16(s[6 * 33], s[7 * 33]);
        *(u32x4*)(WT + (size_t)(ndst0 + n) * K + k0 + 8 * c) = o; }
    asm volatile("s_waitcnt lgkmcnt(0)" ::: "memory");
}
__device__ __forceinline__ int win_src_col(int np) {
    const int pn = np >> 8, half = (np >> 7) & 1, ty = pn >> 2, ch = (pn & 3) * 128 + (np & 127);
    return ty == 0 ? (half ? 1024 + ch : 512 + ch) : ty == 1 ? (half ? 1536 + ch : ch) : (half ? 2560 + ch : 2048 + ch);
}

__device__ __forceinline__ void phase_prep(const Params& p, LAS unsigned char* lds, int gw, int NGW, int wave, int lane) {
    asm volatile("" : "+v"(lane), "+s"(gw), "+s"(wave));
    bf16_t* XN = (bf16_t*)(p.ws + WS_XN);
    LAS float* scr = (LAS float*)(lds + wave * 16384);
    constexpr int I_IN = (DM / 64) * (DIN / 32), I_OUT = (DM / 64) * (DM / 32), I_PW = 4 * (128 / 64) * (128 / 32);
    for (int it = gw; it < I_IN + I_PW; it += NGW) {
        int r = it;
        if (r < I_IN) { const int kb = r / (DIN / 32), nb = r % (DIN / 32); p0_transpose_item(p.w_in, DM, DIN, (bf16_t*)(p.ws + WS_WIN), scr, 64 * kb, win_src_col(32 * nb), 32 * nb, lane); continue; } r -= I_IN;
        const int gidx = r >> 3, q = r & 7; p0_transpose_item(p.pool_w + gidx * 16384, 128, 128, (bf16_t*)(p.ws + WS_PW) + gidx * 16384, scr, 64 * (q >> 2), 32 * (q & 3), 32 * (q & 3), lane);
    }
    f32x4 g[4];
#pragma unroll
    for (int j = 0; j < 4; ++j) g[j] = *((const f32x4*)p.norm_g + lane + 64 * j);
    for (int r = gw; r < MT; r += 2 * NGW) {
        const int r2 = r + NGW; const bool has2 = r2 < MT; const int rb = has2 ? r2 : r;
        const float* xa = (r < MP) ? p.xp + (size_t)r * DM : p.xs + (size_t)(r - MP) * DM;
        const float* xb = (rb < MP) ? p.xp + (size_t)rb * DM : p.xs + (size_t)(rb - MP) * DM;
        f32x4 va[4], vb[4]; float sa = 0.f, sb = 0.f;
#pragma unroll
        for (int j = 0; j < 4; ++j) { va[j] = __builtin_nontemporal_load((const f32x4*)xa + lane + 64 * j); vb[j] = __builtin_nontemporal_load((const f32x4*)xb + lane + 64 * j); }
#pragma unroll
        for (int j = 0; j < 4; ++j) { sa += (va[j].x * va[j].x + va[j].y * va[j].y) + (va[j].z * va[j].z + va[j].w * va[j].w); sb += (vb[j].x * vb[j].x + vb[j].y * vb[j].y) + (vb[j].z * vb[j].z + vb[j].w * vb[j].w); }
        const float ra = rsqrtf(wave_sum(sa) * (1.0f / DM) + EPS), rbv = rsqrtf(wave_sum(sb) * (1.0f / DM) + EPS);
        u32x2* oa = (u32x2*)(XN + (size_t)r * DM) + lane; u32x2* ob = (u32x2*)(XN + (size_t)rb * DM) + lane;
#pragma unroll
        for (int j = 0; j < 4; ++j) { u32x2 w; w.x = cvt_pk_bf16(va[j].x * ra * g[j].x, va[j].y * ra * g[j].y); w.y = cvt_pk_bf16(va[j].z * ra * g[j].z, va[j].w * ra * g[j].w); oa[64 * j] = w; }
        if (has2) {
#pragma unroll
            for (int j = 0; j < 4; ++j) { u32x2 w; w.x = cvt_pk_bf16(vb[j].x * rbv * g[j].x, vb[j].y * rbv * g[j].y); w.y = cvt_pk_bf16(vb[j].z * rbv * g[j].z, vb[j].w * rbv * g[j].w); ob[64 * j] = w; } }
    }
}
__device__ __forceinline__ void phase_late_prep(const Params& p, LAS unsigned char* lds, int gw, int NGW, int wave, int lane) {
    asm volatile("" : "+v"(lane), "+s"(gw), "+s"(wave));
    LAS float* scr = (LAS float*)(lds + wave * 16384);
    constexpr int I_OUT = (DM / 64) * (DM / 32);
    for (int r = gw; r < I_OUT; r += NGW) { const int kb = r / (DM / 32), nb = r % (DM / 32); p0_transpose_item(p.w_out, DM, DM, (bf16_t*)(p.ws + WS_WOUT), scr, 64 * kb, 32 * nb, 32 * nb, lane); }
    for (int i = gw * 64 + lane; i < 128 * 11 * 128; i += NGW * 64) {
        const int b = i / (11 * 128), rem = i - b * (11 * 128);
        *((f32x4*)(p.out + O_POOLS + (size_t)b * 15 * DPL) + rem) = *((const f32x4*)(p.spool + ((size_t)b * 15 + 4) * DPL) + rem);
    }
}

__device__ __forceinline__ F8 unpack8(const u32x4 w) { F8 r;
    r.v[0] = bf_lo(w.x); r.v[1] = bf_hi(w.x); r.v[2] = bf_lo(w.y); r.v[3] = bf_hi(w.y); r.v[4] = bf_lo(w.z); r.v[5] = bf_hi(w.z); r.v[6] = bf_lo(w.w); r.v[7] = bf_hi(w.w); return r; }

struct ConvW { F8 w0, w1, w2; };
__device__ __forceinline__ ConvW load_convw(const Params& p, int c0) { ConvW c; c.w0 = ld_f8(p.conv_w + c0); c.w1 = ld_f8(p.conv_w + DC + c0); c.w2 = ld_f8(p.conv_w + 2 * DC + c0); return c; }

__device__ __forceinline__ void conv_item_prompt(const bf16_t* P2, bf16_t* YB, const ConvW& cw, int r0, int c0) {
    const bf16_t* base = P2 + (size_t)r0 * P2LD + c0;
    u32x4 cuw[10], bsw[8];
    const u32x4 z4 = (u32x4){0u, 0u, 0u, 0u};
    if ((r0 & (SEQ - 1)) != 0) { cuw[0] = *(const u32x4*)(base - 2 * P2LD); cuw[1] = *(const u32x4*)(base - P2LD); } else { cuw[0] = z4; cuw[1] = z4; }
#pragma unroll
    for (int i = 0; i < 8; ++i) { cuw[2 + i] = *(const u32x4*)(base + i * P2LD); bsw[i] = *(const u32x4*)(base + i * P2LD + 512); }
    F8 c2 = unpack8(cuw[0]), c1 = unpack8(cuw[1]);
#pragma unroll
    for (int i = 0; i < 8; ++i) {
        const F8 c0v = unpack8(cuw[2 + i]), bs = unpack8(bsw[i]); F8 y;
#pragma unroll
        for (int e = 0; e < 8; ++e) y.v[e] = bs.v[e] * (cw.w0.v[e] * c2.v[e] + cw.w1.v[e] * c1.v[e] + cw.w2.v[e] * c0v.v[e]);
        { u32x4 wq; wq.x = cvt_pk_bf16(y.v[0], y.v[1]); wq.y = cvt_pk_bf16(y.v[2], y.v[3]); wq.z = cvt_pk_bf16(y.v[4], y.v[5]); wq.w = cvt_pk_bf16(y.v[6], y.v[7]); __builtin_nontemporal_store(wq, (u32x4*)(YB + (size_t)(r0 + i) * DM + c0)); }
        c2 = c1; c1 = c0v;
    }
}
__device__ __forceinline__ void conv_item_sample(const Params& p, const bf16_t* P2, bf16_t* YB, const ConvW& cw, int row, int c0) {
    const int q = row - MP, b = q >> 2, t = q & 3;
    const bf16_t* base = P2 + (size_t)row * P2LD + c0;
    const F8 c0v = ld_bf8(base), bs = ld_bf8(base + 512);
    F8 c1, c2;
    if (t >= 1) c1 = ld_bf8(base - P2LD); else c1 = ld_f8(p.sconv + ((size_t)b * 2 + 1) * DC + c0);
    if (t >= 2) c2 = ld_bf8(base - 2 * P2LD); else c2 = ld_f8(p.sconv + ((size_t)b * 2 + t) * DC + c0);
    F8 y;
#pragma unroll
    for (int e = 0; e < 8; ++e) y.v[e] = bs.v[e] * (cw.w0.v[e] * c2.v[e] + cw.w1.v[e] * c1.v[e] + cw.w2.v[e] * c0v.v[e]);
    { bf16_t* d = YB + (size_t)row * DM + c0;
      st_wt8(d, cvt_pk_bf16(y.v[0], y.v[1]), cvt_pk_bf16(y.v[2], y.v[3])); st_wt8(d + 4, cvt_pk_bf16(y.v[4], y.v[5]), cvt_pk_bf16(y.v[6], y.v[7])); }
    asm volatile("s_waitcnt vmcnt(0)" ::: "memory");
    if ((c0 >> 3) == 0) (void)xb_add(g_ctl + CTL_MIXS + 8 * (q >> 4), 1u);
}
__device__ __forceinline__ void pool_item_sample(const Params& p, const bf16_t* P2, const bf16_t* PWT, bf16_t* YB, int rb, int gi, int lane) {
    const int fr = lane & 15, fq = lane >> 4;
    const int row = rb * 16 + fr, w = 2 << gi;
    const int q = row - MP, b = q >> 2, t = q & 3;
    const bf16_t* vp = P2 + (size_t)row * P2LD + 1024 + gi * 128 + fq * 8;
    const float* sp = p.spool + (size_t)b * 15 * DPL + gi * 128 + fq * 8;
    F8 v0[4], sum[4];
#pragma unroll
    for (int ks = 0; ks < 4; ++ks) { v0[ks] = ld_bf8(vp + ks * 32); sum[ks] = v0[ks]; }
#pragma unroll
    for (int j = 1; j < 4; ++j) {
        if (j < w) {
            const bool ok = (t - j) >= 0;
            const bf16_t* bsrc = ok ? vp - (ptrdiff_t)j * P2LD : vp;
            const float* ssrc = sp + (ok ? 0 : (15 + t - j)) * DPL;
#pragma unroll
            for (int ks = 0; ks < 4; ++ks) { const F8 xb = ld_bf8(bsrc + ks * 32), xs = ld_f8(ssrc + ks * 32);
#pragma unroll
                for (int e = 0; e < 8; ++e) sum[ks].v[e] += ok ? xb.v[e] : xs.v[e]; }
        }
    }
#pragma unroll 4
    for (int j = 4; j < w; ++j) {
        const float* ssrc = sp + (15 + t - j) * DPL;
#pragma unroll
        for (int ks = 0; ks < 4; ++ks) { const F8 xs = ld_f8(ssrc + ks * 32);
#pragma unroll
            for (int e = 0; e < 8; ++e) sum[ks].v[e] += xs.v[e]; }
    }
    const float ic = 1.0f / (float)w;
    bf16x8 af[4];
#pragma unroll
    for (int ks = 0; ks < 4; ++ks) {
        u32x4 o;
        o.x = cvt_pk_bf16(sum[ks].v[0] * ic - v0[ks].v[0], sum[ks].v[1] * ic - v0[ks].v[1]); o.y = cvt_pk_bf16(sum[ks].v[2] * ic - v0[ks].v[2], sum[ks].v[3] * ic - v0[ks].v[3]);
        o.z = cvt_pk_bf16(sum[ks].v[4] * ic - v0[ks].v[4], sum[ks].v[5] * ic - v0[ks].v[5]); o.w = cvt_pk_bf16(sum[ks].v[6] * ic - v0[ks].v[6], sum[ks].v[7] * ic - v0[ks].v[7]);
        af[ks] = __builtin_bit_cast(bf16x8, o);
    }
    const bf16_t* pw = PWT + (size_t)gi * 16384 + fr * 128 + fq * 8;
#pragma unroll 4
    for (int nb = 0; nb < 8; ++nb) {
        f32x4 acc = (f32x4){0.f, 0.f, 0.f, 0.f};
#pragma unroll
        for (int ks = 0; ks < 4; ++ks) {
            const bf16x8 bfrag = *(const bf16x8*)(pw + nb * 16 * 128 + ks * 32);
            acc = __builtin_amdgcn_mfma_f32_16x16x32_bf16(bfrag, af[ks], acc, 0, 0, 0);
        }
        const int col = gi * 128 + nb * 16 + fq * 4;
        const f32x4 sc = *(const f32x4*)(p.pool_scale + col);
        const u32x2 zw = *(const u32x2*)(P2 + (size_t)row * P2LD + 1536 + col);
        u32x2 o; o.x = cvt_pk_bf16(acc[0] * sc[0] * bf_lo(zw.x), acc[1] * sc[1] * bf_hi(zw.x)); o.y = cvt_pk_bf16(acc[2] * sc[2] * bf_lo(zw.y), acc[3] * sc[3] * bf_hi(zw.y));
        *(u32x2*)(YB + (size_t)row * DM + 512 + col) = o;
    }
}

constexpr int PT_ROWS = 80, PT_ROWB = 272, PT_VBYTES = PT_ROWS * PT_ROWB, PT_WBYTES = 128 * PT_ROWB, PT_BUF = PT_VBYTES + PT_WBYTES;
struct PoolRegs { u32x4 v[3]; u32x4 w[4]; u32x2 zs[4]; };
__device__ __forceinline__ void pool_load(const bf16_t* P2, const bf16_t* PWT, int item, PoolRegs& R, int tid) {
    const int gi = item & 3, r0 = (item >> 2) * 64, t0 = r0 & (SEQ - 1);
    { const int lane = tid & 63, wave = tid >> 6, fr = lane & 15, fq = lane >> 4, row = r0 + (wave & 3) * 16 + fr;
#pragma unroll
      for (int nb = 0; nb < 4; ++nb) R.zs[nb] = *(const u32x2*)(P2 + (size_t)row * P2LD + 1536 + gi * 128 + ((wave >> 2) * 4 + nb) * 16 + fq * 4); }
    const bf16_t* vb = P2 + (ptrdiff_t)(r0 - 16) * P2LD + 1024 + gi * 128;
#pragma unroll
    for (int k = 0; k < 3; ++k) { const int idx = tid + 512 * k, lrow = idx >> 4;
        const bool valid = (idx < PT_ROWS * 16) && (t0 != 0 || lrow >= 16);
        R.v[k] = (u32x4){0u, 0u, 0u, 0u};
        if (valid) R.v[k] = *(const u32x4*)(vb + (ptrdiff_t)lrow * P2LD + (idx & 15) * 8); }
    const bf16_t* wb = PWT + (size_t)gi * 16384;
#pragma unroll
    for (int k = 0; k < 4; ++k) { const int idx = tid + 512 * k; R.w[k] = *(const u32x4*)(wb + idx * 8); }
}
__device__ __forceinline__ void pool_store_lds(LAS unsigned char* buf, const PoolRegs& R, int tid) {
#pragma unroll
    for (int k = 0; k < 3; ++k) { const int idx = tid + 512 * k; if (idx < PT_ROWS * 16) *(LAS u32x4*)(buf + (idx >> 4) * PT_ROWB + (idx & 15) * 16) = R.v[k]; }
#pragma unroll
    for (int k = 0; k < 4; ++k) { const int idx = tid + 512 * k, n = idx >> 4, c16 = idx & 15, ks = c16 >> 2, cc = c16 & 3;
        LAS unsigned char* rowp = buf + PT_VBYTES + n * PT_ROWB + ks * 64 + (cc >> 1) * 8;
        *(LAS u32x2*)(rowp + ((2 * cc) & 3) * 16) = (u32x2){R.w[k].x, R.w[k].y};
        *(LAS u32x2*)(rowp + ((2 * cc + 1) & 3) * 16) = (u32x2){R.w[k].z, R.w[k].w}; }
}
__device__ __forceinline__ void pool_compute(const Params& p, LAS unsigned char* buf, const u32x2 (&zs)[4], bf16_t* YB, int item, int wave, int lane) {
    const int gi = item & 3, r0 = (item >> 2) * 64, t0 = r0 & (SEQ - 1), w = 2 << gi;
    const int fr = lane & 15, fq = lane >> 4, sb = wave & 3, nh = wave >> 2;
    const int lr = sb * 16 + fr, row = r0 + lr, t = t0 + lr;
    f32x4 sc[4];
#pragma unroll
    for (int nb = 0; nb < 4; ++nb) { const int col = gi * 128 + (nh * 4 + nb) * 16 + fq * 4; sc[nb] = *(const f32x4*)(p.pool_scale + col); }
    const int cnti = (t + 1 < w) ? (t + 1) : w;
    const float ic = 1.0f / (float)cnti;
    float bw[8];
#pragma unroll
    for (int e = 0; e < 8; ++e) { const int d = fr - (8 * fq + e - 16); bw[e] = ((d >= 0 && d < w) ? ic : 0.0f) - (d == 0 ? 1.0f : 0.0f); }
    u32x4 bo; bo.x = cvt_pk_bf16(bw[0], bw[1]); bo.y = cvt_pk_bf16(bw[2], bw[3]); bo.z = cvt_pk_bf16(bw[4], bw[5]); bo.w = cvt_pk_bf16(bw[6], bw[7]);
    const bf16x8 band = __builtin_bit_cast(bf16x8, bo);
    const unsigned tra = (unsigned)(size_t)(buf + (sb * 16 + 8 * fq + (fr >> 2)) * PT_ROWB + (fr & 3) * 8);
    f32x4 pl[8];
    u32x2 xr[16];
    asm volatile(
        "ds_read_b64_tr_b16 %0, %16\n\tds_read_b64_tr_b16 %1, %16 offset:1088\n\t"
        "ds_read_b64_tr_b16 %2, %16 offset:32\n\tds_read_b64_tr_b16 %3, %16 offset:1120\n\t"
        "ds_read_b64_tr_b16 %4, %16 offset:64\n\tds_read_b64_tr_b16 %5, %16 offset:1152\n\t"
        "ds_read_b64_tr_b16 %6, %16 offset:96\n\tds_read_b64_tr_b16 %7, %16 offset:1184\n\t"
        "ds_read_b64_tr_b16 %8, %16 offset:128\n\tds_read_b64_tr_b16 %9, %16 offset:1216\n\t"
        "ds_read_b64_tr_b16 %10, %16 offset:160\n\tds_read_b64_tr_b16 %11, %16 offset:1248\n\t"
        "ds_read_b64_tr_b16 %12, %16 offset:192\n\tds_read_b64_tr_b16 %13, %16 offset:1280\n\t"
        "ds_read_b64_tr_b16 %14, %16 offset:224\n\tds_read_b64_tr_b16 %15, %16 offset:1312\n\t"
        "s_waitcnt lgkmcnt(0)"
        : "=&v"(xr[0]), "=&v"(xr[1]), "=&v"(xr[2]), "=&v"(xr[3]), "=&v"(xr[4]), "=&v"(xr[5]), "=&v"(xr[6]), "=&v"(xr[7]),
          "=&v"(xr[8]), "=&v"(xr[9]), "=&v"(xr[10]), "=&v"(xr[11]), "=&v"(xr[12]), "=&v"(xr[13]), "=&v"(xr[14]), "=&v"(xr[15])
        : "v"(tra) : "memory");
    static_assert(4 * PT_ROWB == 1088, "transposed-read immediates assume 272-byte rows");
#pragma unroll
    for (int cbk = 0; cbk < 8; ++cbk) {
        const bf16x8 xf = __builtin_bit_cast(bf16x8, (u32x4){xr[2 * cbk].x, xr[2 * cbk].y, xr[2 * cbk + 1].x, xr[2 * cbk + 1].y});
        pl[cbk] = __builtin_amdgcn_mfma_f32_16x16x32_bf16(xf, band, (f32x4){0.f, 0.f, 0.f, 0.f}, 0, 0, 0);
    }
    bf16x8 af[4];
#pragma unroll
    for (int ks = 0; ks < 4; ++ks) {
        u32x4 o; o.x = pk_bf16_c(pl[2 * ks][0], pl[2 * ks][1]); o.y = pk_bf16_c(pl[2 * ks][2], pl[2 * ks][3]); o.z = pk_bf16_c(pl[2 * ks + 1][0], pl[2 * ks + 1][1]); o.w = pk_bf16_c(pl[2 * ks + 1][2], pl[2 * ks + 1][3]);
        af[ks] = __builtin_bit_cast(bf16x8, o);
    }
    const LAS unsigned char* wrow = buf + PT_VBYTES + fr * PT_ROWB + fq * 16;
#pragma unroll
    for (int nb = 0; nb < 4; ++nb) {
        const int nbg = nh * 4 + nb;
        f32x4 acc = (f32x4){0.f, 0.f, 0.f, 0.f};
#pragma unroll
        for (int ks = 0; ks < 4; ++ks) {
            const bf16x8 bfrag = *(const LAS bf16x8*)(wrow + nbg * 16 * PT_ROWB + ks * 64);
            acc = __builtin_amdgcn_mfma_f32_16x16x32_bf16(bfrag, af[ks], acc, 0, 0, 0);
        }
        const int col = gi * 128 + nbg * 16 + fq * 4;
        u32x2 o; o.x = cvt_pk_bf16(acc[0] * sc[nb][0] * bf_lo(zs[nb].x), acc[1] * sc[nb][1] * bf_hi(zs[nb].x)); o.y = cvt_pk_bf16(acc[2] * sc[nb][2] * bf_lo(zs[nb].y), acc[3] * sc[nb][3] * bf_hi(zs[nb].y));
        __builtin_nontemporal_store(o, (u32x2*)(YB + (size_t)row * DM + 512 + col));
    }
}

__device__ __forceinline__ void phase_mix_prompt(const Params& p, LAS unsigned char* lds, int wi, int NW, int wave, int lane) {
    asm volatile("" : "+v"(lane), "+s"(wi), "+s"(wave));
    const bf16_t* P2 = (const bf16_t*)(p.ws + WS_P2); const bf16_t* PWT = (const bf16_t*)(p.ws + WS_PW); bf16_t* YB = (bf16_t*)(p.ws + WS_YB);
    const int tid = wave * 64 + lane;
    constexpr int NPOOL = (MP / 64) * 4, NCONV = MP / 8;
    PoolRegs Ra, Rb; int item = wi, buf = 0;
    if (item < NPOOL) pool_load(P2, PWT, item, Ra, tid);
    if (item + NW < NPOOL) pool_load(P2, PWT, item + NW, Rb, tid);
    for (; item < NPOOL; item += NW) {
        LAS unsigned char* b = lds + buf * PT_BUF;
        pool_store_lds(b, Ra, tid);
        u32x2 zc[4];
#pragma unroll
        for (int nb = 0; nb < 4; ++nb) zc[nb] = Ra.zs[nb];
        __syncthreads();
        Ra = Rb;
        if (item + 2 * NW < NPOOL) pool_load(P2, PWT, item + 2 * NW, Rb, tid);
        pool_compute(p, b, zc, YB, item, wave, lane);
        buf ^= 1;
    }
    const ConvW cw = load_convw(p, lane * 8);
    for (int it = wi * 8 + wave; it < NCONV; it += NW * 8) conv_item_prompt(P2, YB, cw, it * 8, lane * 8);
}

constexpr int SP_ROWB = 528, SP_SEQB = 19 * SP_ROWB;
struct SPre { bf16x8 bfr[4]; f32x4 sc; f32x4 sv[4]; };
__device__ __forceinline__ void pool_wg_item_sample_pre(const Params& p, const bf16_t* PWT, int item, int wave, int lane, SPre& R) {
    const int tid = wave * 64 + lane, rb = item >> 2, gi = item & 3, fr = lane & 15, fq = lane >> 4;
    const bf16_t* pw = PWT + (size_t)gi * 16384 + (size_t)(wave * 16 + fr) * 128 + fq * 8;
#pragma unroll
    for (int ks = 0; ks < 4; ++ks) R.bfr[ks] = *(const bf16x8*)(pw + ks * 32);
    R.sc = *(const f32x4*)(p.pool_scale + gi * 128 + wave * 16 + fq * 4);
#pragma unroll
    for (int k = 0; k < 4; ++k) { const int idx = tid + 512 * k; R.sv[k] = (f32x4){0.f, 0.f, 0.f, 0.f};
        if (idx < 1920) { const int s = idx / 480, rem = idx - s * 480, r = rem >> 5, c4 = rem & 31;
            R.sv[k] = __builtin_nontemporal_load((const f32x4*)(p.spool + ((size_t)(rb * 4 + s) * 15 + r) * DPL + gi * 128 + c4 * 4)); } }
}
__device__ __forceinline__ void pool_wg_item_sample(const Params& p, LAS unsigned char* lds, const bf16_t* P2, const bf16_t* PWT, bf16_t* YB, int item, int wave, int lane, bool use_pre, const SPre& pre) {
    const int tid = wave * 64 + lane, rb = item >> 2, gi = item & 3, w = 2 << gi;
    const int fr = lane & 15, fq = lane >> 4;
    const int row = MP + rb * 16 + fr, sq = fr >> 2, t = fr & 3;
    const bf16_t* pw = PWT + (size_t)gi * 16384 + (size_t)(wave * 16 + fr) * 128 + fq * 8;
    bf16x8 bfr[4];
#pragma unroll
    for (int ks = 0; ks < 4; ++ks) bfr[ks] = use_pre ? pre.bfr[ks] : *(const bf16x8*)(pw + ks * 32);
    const int col = gi * 128 + wave * 16 + fq * 4;
    const f32x4 sc = use_pre ? pre.sc : *(const f32x4*)(p.pool_scale + col);
    const u32x2 zw = *(const u32x2*)(P2 + (size_t)row * P2LD + 1536 + col);
    f32x4 sv[4]; u32x4 vv = (u32x4){0u, 0u, 0u, 0u};
#pragma unroll
    for (int k = 0; k < 4; ++k) { const int idx = tid + 512 * k; sv[k] = (f32x4){0.f, 0.f, 0.f, 0.f};
        if (use_pre) sv[k] = pre.sv[k];
        else if (idx < 1920) { const int s = idx / 480, rem = idx - s * 480, r = rem >> 5, c4 = rem & 31;
            sv[k] = *(const f32x4*)(p.spool + ((size_t)(rb * 4 + s) * 15 + r) * DPL + gi * 128 + c4 * 4); } }
    if (tid < 256) vv = *(const u32x4*)(P2 + (size_t)(MP + rb * 16 + (tid >> 4)) * P2LD + 1024 + gi * 128 + (tid & 15) * 8);
#pragma unroll
    for (int k = 0; k < 4; ++k) { const int idx = tid + 512 * k;
        if (idx < 1920) { const int s = idx / 480, rem = idx - s * 480, r = rem >> 5, c4 = rem & 31; *(LAS f32x4*)(lds + s * SP_SEQB + r * SP_ROWB + c4 * 16) = sv[k]; } }
    if (tid < 256) { const int lr = tid >> 4, s = lr >> 2, tt = lr & 3, c8 = tid & 15; const F8 f = unpack8(vv);
        LAS unsigned char* d = lds + s * SP_SEQB + (15 + tt) * SP_ROWB + c8 * 32;
        *(LAS f32x4*)d = (f32x4){f.v[0], f.v[1], f.v[2], f.v[3]}; *(LAS f32x4*)(d + 16) = (f32x4){f.v[4], f.v[5], f.v[6], f.v[7]}; }
    __syncthreads();
    const LAS unsigned char* base = lds + sq * SP_SEQB + (15 + t) * SP_ROWB + fq * 32;
    const float ic = 1.0f / (float)w;
    bf16x8 af[4];
#pragma unroll
    for (int ks = 0; ks < 4; ++ks) {
        const f32x4 a0 = *(const LAS f32x4*)(base + ks * 128), a1 = *(const LAS f32x4*)(base + ks * 128 + 16);
        f32x4 s0 = a0, s1 = a1;
#pragma unroll 4
        for (int j = 1; j < w; ++j) { s0 += *(const LAS f32x4*)(base - j * SP_ROWB + ks * 128); s1 += *(const LAS f32x4*)(base - j * SP_ROWB + ks * 128 + 16); }
        const f32x4 p0 = s0 * ic - a0, p1 = s1 * ic - a1;
        u32x4 o; o.x = cvt_pk_bf16(p0[0], p0[1]); o.y = cvt_pk_bf16(p0[2], p0[3]); o.z = cvt_pk_bf16(p1[0], p1[1]); o.w = cvt_pk_bf16(p1[2], p1[3]);
        af[ks] = __builtin_bit_cast(bf16x8, o);
    }
    f32x4 acc = (f32x4){0.f, 0.f, 0.f, 0.f};
#pragma unroll
    for (int ks = 0; ks < 4; ++ks) acc = __builtin_amdgcn_mfma_f32_16x16x32_bf16(bfr[ks], af[ks], acc, 0, 0, 0);
    u32x2 o; o.x = cvt_pk_bf16(acc[0] * sc[0] * bf_lo(zw.x), acc[1] * sc[1] * bf_hi(zw.x)); o.y = cvt_pk_bf16(acc[2] * sc[2] * bf_lo(zw.y), acc[3] * sc[3] * bf_hi(zw.y));
    st_wt8(YB + (size_t)row * DM + 512 + col, o.x, o.y);
    asm volatile("s_waitcnt vmcnt(0)" ::: "memory");
    __syncthreads();
    if (tid == 0) (void)xb_add(g_ctl + CTL_MIXS + 8 * rb, 1u);
}

__device__ __forceinline__ void phase_mix_sample_old(const Params& p, int gw, int NGW, int lane) {
    asm volatile("" : "+v"(lane), "+s"(gw));
    const bf16_t* P2 = (const bf16_t*)(p.ws + WS_P2); const bf16_t* PWT = (const bf16_t*)(p.ws + WS_PW); bf16_t* YB = (bf16_t*)(p.ws + WS_YB);
    constexpr int NPOOL = (MS / 16) * 4;
    for (int item = gw; item < NPOOL + MS; item += NGW) {
        if (item < NPOOL) pool_item_sample(p, P2, PWT, YB, MP / 16 + (item >> 2), item & 3, lane);
        else { const ConvW cw = load_convw(p, lane * 8); conv_item_sample(p, P2, YB, cw, MP + (item - NPOOL), lane * 8); }
    }
}

__device__ __forceinline__ void phase_mix_sample(const Params& p, LAS unsigned char* lds, int c, int G, int wave, int lane, bool has_pre, const SPre& pre) {
    asm volatile("" : "+v"(lane), "+s"(c), "+s"(wave));
    const bf16_t* P2 = (const bf16_t*)(p.ws + WS_P2); const bf16_t* PWT = (const bf16_t*)(p.ws + WS_PW); bf16_t* YB = (bf16_t*)(p.ws + WS_YB);
    constexpr int NPOOL = (MS / 16) * 4;
    for (int item = c; item < NPOOL; item += G) pool_wg_item_sample(p, lds, P2, PWT, YB, item, wave, lane, has_pre && item == c, pre);
    const int NW8 = G * 8; int gwv = ((c + G - (NPOOL % G)) % G) * 8 + wave;
    const ConvW cw = load_convw(p, lane * 8);
    for (int it = gwv; it < MS; it += NW8) conv_item_sample(p, P2, YB, cw, MP + it, lane * 8);
}

__device__ __forceinline__ void phase_final(const Params& p, int r_lo, int r_hi, int gw, int NGW, int lane) {
    asm volatile("" : "+v"(lane), "+s"(gw));
    f32x4 g[4];
#pragma unroll
    for (int j = 0; j < 4; ++j) g[j] = *((const f32x4*)p.final_g + lane + 64 * j);
    for (int r = r_lo + gw; r < r_hi; r += 4 * NGW) {
        f32x4 v[4][4]; f32x4* rowp[4]; bool has[4];
#pragma unroll
        for (int k = 0; k < 4; ++k) { const int rk = r + k * NGW; has[k] = rk < r_hi; rowp[k] = (f32x4*)(p.out + (size_t)(has[k] ? rk : r) * DM) + lane;
#pragma unroll
            for (int j = 0; j < 4; ++j) v[k][j] = rowp[k][64 * j]; }
#pragma unroll
        for (int k = 0; k < 4; ++k) { float s = 0.f;
#pragma unroll
            for (int j = 0; j < 4; ++j) s += (v[k][j].x * v[k][j].x + v[k][j].y * v[k][j].y) + (v[k][j].z * v[k][j].z + v[k][j].w * v[k][j].w);
            const float rinv = rsqrtf(wave_sum(s) * (1.0f / DM) + EPS);
            if (has[k]) {
#pragma unroll
                for (int j = 0; j < 4; ++j) rowp[k][64 * j] = v[k][j] * rinv * g[j]; } }
    }
}

__device__ __forceinline__ void g1s_item(const Params& p, int item, int lane) {
    const bf16_t* XN = (const bf16_t*)(p.ws + WS_XN); const bf16_t* WT = (const bf16_t*)(p.ws + WS_WIN); bf16_t* P2 = (bf16_t*)(p.ws + WS_P2);
    const int fr = lane & 15, fq = lane >> 4;
    const int rb = item / 48, cgi = item - rb * 48, pn = cgi >> 2, sub = cgi & 3;
    const int row = MP + rb * 16 + fr;
    const bf16_t* ap = XN + (size_t)row * DM + fq * 8;
    const bf16_t* bp = WT + (size_t)(pn * 256 + sub * 32 + fr) * DM + fq * 8;
    f32x4 acc[4];
#pragma unroll
    for (int i = 0; i < 4; ++i) acc[i] = (f32x4){0.f, 0.f, 0.f, 0.f};
#pragma unroll 4
    for (int ks = 0; ks < DM / 32; ++ks) {
        const bf16x8 a = *(const bf16x8*)(ap + ks * 32);
#pragma unroll
        for (int i = 0; i < 4; ++i) {
            const bf16x8 b = *(const bf16x8*)(bp + (size_t)((i >> 1) * 128 + (i & 1) * 16) * DM + ks * 32);
            acc[i] = __builtin_amdgcn_mfma_f32_16x16x32_bf16(b, a, acc[i], 0, 0, 0);
        }
    }
    const int ty = pn >> 2, q = row - MP, sb = q >> 2, st = q & 3;
#pragma unroll
    for (int nbk = 0; nbk < 2; ++nbk) {
        const int loc = (pn & 3) * 128 + sub * 32 + nbk * 16 + fq * 4;
        const f32x4 a = acc[nbk], b = acc[2 + nbk];
        bf16_t* prow = P2 + (size_t)row * P2LD + loc;
        if (ty == 0) {
            const f32x4 cu = a * b;
            u32x2 o; o.x = cvt_pk_bf16(cu[0], cu[1]); o.y = cvt_pk_bf16(cu[2], cu[3]); *(u32x2*)prow = o;
            if (st >= 2) *(f32x4*)(p.out + O_CONVS + ((size_t)sb * 2 + (st - 2)) * DC + loc) = cu;
        } else if (ty == 1) {
            u32x2 o; o.x = cvt_pk_bf16(a[0] * silu(b[0]), a[1] * silu(b[1])); o.y = cvt_pk_bf16(a[2] * silu(b[2]), a[3] * silu(b[3])); *(u32x2*)(prow + 512) = o;
        } else {
            u32x2 o; o.x = cvt_pk_bf16(a[0], a[1]); o.y = cvt_pk_bf16(a[2], a[3]); *(u32x2*)(prow + 1024) = o;
            u32x2 z; z.x = cvt_pk_bf16(silu(b[0]), silu(b[1])); z.y = cvt_pk_bf16(silu(b[2]), silu(b[3])); *(u32x2*)(prow + 1536) = z;
            *(f32x4*)(p.out + O_POOLS + ((size_t)sb * 15 + 11 + st) * DPL + loc) = a;
        }
    }
}
__device__ __forceinline__ void g2s_item(const Params& p, int item, int lane) {
    const bf16_t* YB = (const bf16_t*)(p.ws + WS_YB); const bf16_t* WT = (const bf16_t*)(p.ws + WS_WOUT);
    const int fr = lane & 15, fq = lane >> 4;
    const int rb = item >> 6, cb = item & 63;
    const int row = MP + rb * 16 + fr;
    const bf16_t* ap = YB + (size_t)row * DM + fq * 8;
    const bf16_t* bp = WT + (size_t)(cb * 16 + fr) * DM + fq * 8;
    f32x4 acc = (f32x4){0.f, 0.f, 0.f, 0.f};
#pragma unroll 16
    for (int ks = 0; ks < DM / 32; ++ks) {
        const bf16x8 a = *(const bf16x8*)(ap + ks * 32);
        const bf16x8 b = *(const bf16x8*)(bp + ks * 32);
        acc = __builtin_amdgcn_mfma_f32_16x16x32_bf16(b, a, acc, 0, 0, 0);
    }
    const size_t o = (size_t)(row - MP) * DM + cb * 16 + fq * 4;
    const f32x4 h = acc + *(const f32x4*)(p.xs + o);
    float* dst = p.out + (size_t)MP * DM + o;
    asm volatile("s_nop 1\n\tglobal_store_dwordx4 %0, %1, off sc0 sc1" :: "v"(dst), "v"(h) : "memory");
    asm volatile("s_waitcnt vmcnt(0)" ::: "memory");
    unsigned old = 0;
    if (lane == 0) old = xb_add(g_ctl + CTL_CNT + 64 * 68 + 16 * rb, 1u);
    old = __builtin_amdgcn_readfirstlane(old);
    if (old == 63u) {
        __builtin_amdgcn_fence(__ATOMIC_ACQUIRE, "agent");
        asm volatile("s_waitcnt vmcnt(0)" ::: "memory");
        f32x4 g[4];
#pragma unroll
        for (int j = 0; j < 4; ++j) g[j] = *((const f32x4*)p.final_g + lane + 64 * j);
        for (int r4 = 0; r4 < 16; r4 += 4) {
            f32x4 v[4][4];
#pragma unroll
            for (int k = 0; k < 4; ++k)
#pragma unroll
                for (int j = 0; j < 4; ++j) v[k][j] = *((const f32x4*)(p.out + (size_t)(MP + rb * 16 + r4 + k) * DM) + lane + 64 * j);
#pragma unroll
            for (int k = 0; k < 4; ++k) { float s = 0.f;
#pragma unroll
                for (int j = 0; j < 4; ++j) s += (v[k][j].x * v[k][j].x + v[k][j].y * v[k][j].y) + (v[k][j].z * v[k][j].z + v[k][j].w * v[k][j].w);
                const float rinv = rsqrtf(wave_sum(s) * (1.0f / DM) + EPS);
#pragma unroll
                for (int j = 0; j < 4; ++j) *((f32x4*)(p.out + (size_t)(MP + rb * 16 + r4 + k) * DM) + lane + 64 * j) = v[k][j] * rinv * g[j]; }
        }
    }
}

__device__ __forceinline__ void g2s_wg_item(const Params& p, LAS unsigned char* lds, int item, int wave, int lane) {
    const bf16_t* YB = (const bf16_t*)(p.ws + WS_YB); const bf16_t* WT = (const bf16_t*)(p.ws + WS_WOUT);
    const int fr = lane & 15, fq = lane >> 4;
    const int rb = item >> 3, cgp = item & 7;
    const int row = MP + rb * 16 + fr;
    const bf16_t* ap = YB + (size_t)row * DM + wave * 128 + fq * 8;
    const bf16_t* bp = WT + (size_t)(cgp * 128 + fr) * DM + wave * 128 + fq * 8;
    bf16x8 b[8][4];
#pragma unroll
    for (int nb = 0; nb < 8; ++nb)
#pragma unroll
        for (int ks = 0; ks < 4; ++ks) b[nb][ks] = *(const bf16x8*)(bp + (size_t)nb * 16 * DM + ks * 32);
    const size_t o = (size_t)(row - MP) * DM + cgp * 128 + wave * 16 + fq * 4;
    const f32x4 xres = __builtin_nontemporal_load((const f32x4*)(p.xs + o));
    if (threadIdx.x == 0) {
        unsigned* cm = g_ctl + CTL_MIXS + 8 * rb; unsigned sp = 0;
        while (xb_ld(cm) < 20u) { __builtin_amdgcn_s_sleep(1); if ((++sp & 255u) == 0u) { if (xb_ld(g_ctl + XB_TMO)) break; if (sp > XB_SPIN_CAP) { atomicAdd(g_ctl + XB_TMO, 1u); break; } } }
        __builtin_amdgcn_fence(__ATOMIC_ACQUIRE, "agent");
        asm volatile("s_waitcnt vmcnt(0)" ::: "memory");
    }
    __syncthreads();
    bf16x8 a[4];
#pragma unroll
    for (int ks = 0; ks < 4; ++ks) a[ks] = *(const bf16x8*)(ap + ks * 32);
    f32x4 acc[8];
#pragma unroll
    for (int nb = 0; nb < 8; ++nb) { acc[nb] = (f32x4){0.f, 0.f, 0.f, 0.f};
#pragma unroll
        for (int ks = 0; ks < 4; ++ks) acc[nb] = __builtin_amdgcn_mfma_f32_16x16x32_bf16(b[nb][ks], a[ks], acc[nb], 0, 0, 0); }
#pragma unroll
    for (int nb = 0; nb < 8; ++nb) *(LAS f32x4*)(lds + ((wave * 8 + nb) * 64 + lane) * 16) = acc[nb];
    __syncthreads();
    f32x4 s = (f32x4){0.f, 0.f, 0.f, 0.f};
#pragma unroll
    for (int sw = 0; sw < 8; ++sw) s += *(const LAS f32x4*)(lds + ((sw * 8 + wave) * 64 + lane) * 16);
    const f32x4 h = s + xres;
    float* dst = p.out + (size_t)MP * DM + o;
    asm volatile("s_nop 1\n\tglobal_store_dwordx4 %0, %1, off sc0 sc1" :: "v"(dst), "v"(h) : "memory");
    asm volatile("s_waitcnt vmcnt(0)" ::: "memory");
    __syncthreads();
    volatile LAS unsigned* flag = (volatile LAS unsigned*)(lds + 65536);
    if (threadIdx.x == 0) {
        const unsigned old = xb_add(g_ctl + CTL_CNT + 64 * 68 + 16 * rb, 1u);
        if (old == 7u) { __builtin_amdgcn_fence(__ATOMIC_ACQUIRE, "agent"); asm volatile("s_waitcnt vmcnt(0)" ::: "memory"); }
        flag[0] = (old == 7u) ? 1u : 0u;
    }
    __syncthreads();
    if (flag[0]) {
        f32x4 g[4], v[2][4];
#pragma unroll
        for (int j = 0; j < 4; ++j) g[j] = *((const f32x4*)p.final_g + lane + 64 * j);
#pragma unroll
        for (int k = 0; k < 2; ++k)
#pragma unroll
            for (int j = 0; j < 4; ++j) v[k][j] = *((const f32x4*)(p.out + (size_t)(MP + rb * 16 + wave * 2 + k) * DM) + lane + 64 * j);
#pragma unroll
        for (int k = 0; k < 2; ++k) { float ss = 0.f;
#pragma unroll
            for (int j = 0; j < 4; ++j) ss += (v[k][j].x * v[k][j].x + v[k][j].y * v[k][j].y) + (v[k][j].z * v[k][j].z + v[k][j].w * v[k][j].w);
            const float rinv = rsqrtf(wave_sum(ss) * (1.0f / DM) + EPS);
#pragma unroll
            for (int j = 0; j < 4; ++j) *((f32x4*)(p.out + (size_t)(MP + rb * 16 + wave * 2 + k) * DM) + lane + 64 * j) = v[k][j] * rinv * g[j]; }
    }
    __syncthreads();
}

__device__ __forceinline__ void wg_publish(unsigned* cnt) {
    asm volatile("s_waitcnt vmcnt(0)" ::: "memory");
    __syncthreads();
    if (threadIdx.x == 0) {
        __builtin_amdgcn_fence(__ATOMIC_RELEASE, "agent");
        asm volatile("s_waitcnt vmcnt(0)" ::: "memory");
        (void)xb_add(cnt, 1u);
    }
}
__device__ __forceinline__ void wg_wait(unsigned* cnt, unsigned need, unsigned* tmo) {
    if (threadIdx.x == 0) {
        unsigned sp = 0;
        while (xb_ld(cnt) < need) { __builtin_amdgcn_s_sleep(1); if ((++sp & 255u) == 0u) { if (xb_ld(tmo)) break; if (sp > XB_SPIN_CAP) { atomicAdd(tmo, 1u); break; } } }
        __builtin_amdgcn_fence(__ATOMIC_ACQUIRE, "agent");
        asm volatile("s_waitcnt vmcnt(0)" ::: "memory");
    }
    __syncthreads();
}

constexpr int NS1 = (MS / HALF) * (DIN / BM), NS2 = 2 * (DM / BM);

__global__ void __launch_bounds__(512, 2) fwd_megakernel(Params p) {
    extern __shared__ __attribute__((aligned(16))) unsigned char shm[];
    LAS unsigned char* lds = (LAS unsigned char*)shm;
    cg::grid_group grid = cg::this_grid();
    if (p.never) grid.sync();
    volatile LAS unsigned* xst = (volatile LAS unsigned*)(lds + STAGE_BYTES);
    if (threadIdx.x == 0) { xst[0] = 0u; xst[1] = 0u; xst[2] = 0u; xst[3] = 0u; }
    __syncthreads();
    const XcdBarrier xb = xcd_barrier_post(g_ctl, xst);
    const int tid = threadIdx.x, wave = __builtin_amdgcn_readfirstlane(tid >> 6), lane = tid & 63;
    const int G = (int)gridDim.x, c = (int)blockIdx.x;
    const int gw = c * 8 + wave, NGW = G * 8;

    phase_prep(p, lds, gw, NGW, wave, lane);
    xcd_barrier(xb);
    { const Gemm g{(const bf16_t*)(p.ws + WS_XN), (const bf16_t*)(p.ws + WS_WIN), MT, DIN, DM};
      { const EpiMix E{(bf16_t*)(p.ws + WS_P2), p.out, 2};
        Order S; S.init(MP / BM, DIN / BM, 0, G, c);
        gemm_phase(lds, g, S, E); }
      xcd_barrier(xb);
      { const EpiMix E{(bf16_t*)(p.ws + WS_P2), p.out, 1};
        Order S; S.init(MS / HALF, DIN / BM, 0, G, c, MP, HALF);
        gemm_phase<EpiMix, Order, true>(lds, g, S, E); }
      if (c >= NS1) { phase_mix_prompt(p, lds, c - NS1, G - NS1, wave, lane); __syncthreads(); phase_late_prep(p, lds, (c - NS1) * 8 + wave, (G - NS1) * 8, wave, lane); }
      xcd_barrier(xb, true);
    }
    SPre spre; const bool has_pre = c < (MS / 16) * 4;
    if (has_pre) pool_wg_item_sample_pre(p, (const bf16_t*)(p.ws + WS_PW), c, wave, lane, spre);
    xcd_barrier_finish(xb);
    phase_mix_sample(p, lds, c, G, wave, lane, has_pre, spre);
    __syncthreads();
    { int cs = c, ws_ = wave; asm volatile("" : "+s"(cs), "+s"(ws_)); int ln = lane; asm volatile("" : "+v"(ln));
      for (int item = cs; item < (MS / 16) * 8; item += G) g2s_wg_item(p, lds, item, ws_, ln); }
    { const Gemm g{(const bf16_t*)(p.ws + WS_YB), (const bf16_t*)(p.ws + WS_WOUT), MT, DM, DM};
      const EpiOutNorm E{p.out, p.xp, p.final_g, (float*)(p.ws + WS_STATS), g_ctl + CTL_CNT, g_ctl + XB_TMO};
      Order S; S.init(MP / BM, DM / BM, 0, G, c);
      gemm_phase(lds, g, S, E); }
    __syncthreads();
    if (threadIdx.x == 0) { const unsigned old = xb_add(g_ctl + CTL_EXIT, 1u); xst[0] = (old == (unsigned)G - 1u) ? 1u : 0u; }
    __syncthreads();
    if (xst[0]) { for (int i = threadIdx.x; i < CTL_WORDS; i += 512) g_ctl[i] = 0u; }
}

extern "C" void kernel_launch(void* const* d_in, const int* in_sizes, int n_in, void* d_out, int out_size, void* d_ws, size_t ws_size, hipStream_t stream) {
    static int grid_blocks = 0;
    if (!grid_blocks) {
        int dev = 0, cus = 0, per_cu = 0;
        (void)hipGetDevice(&dev);
        (void)hipDeviceGetAttribute(&cus, hipDeviceAttributeMultiprocessorCount, dev);
        if (hipFuncSetAttribute((const void*)fwd_megakernel, hipFuncAttributeMaxDynamicSharedMemorySize, LDS_BYTES) != hipSuccess) fprintf(stderr, "hipFuncSetAttribute failed\n");
        (void)hipOccupancyMaxActiveBlocksPerMultiprocessor(&per_cu, (const void*)fwd_megakernel, 512, LDS_BYTES);
        if (per_cu < 1) { fprintf(stderr, "occupancy query says %d blocks/CU\n", per_cu); per_cu = 1; }
        grid_blocks = cus * per_cu;
        if (grid_blocks != 256) fprintf(stderr, "this kernel is built for 256 workgroups (one per CU of a 256-CU device); got %d\n", grid_blocks);
        (void)hipGetLastError();
    }
    Params p{};
    p.xp = (const float*)d_in[0]; p.xs = (const float*)d_in[1]; p.sconv = (const float*)d_in[2]; p.spool = (const float*)d_in[3];
    p.norm_g = (const float*)d_in[4]; p.w_in = (const float*)d_in[5]; p.conv_w = (const float*)d_in[6]; p.pool_w = (const float*)d_in[7];
    p.pool_scale = (const float*)d_in[8]; p.w_out = (const float*)d_in[9]; p.final_g = (const float*)d_in[10];
    p.out = (float*)d_out; p.ws = (unsigned char*)d_ws;
    void* args[] = {&p};
    hipError_t e = hipLaunchCooperativeKernel((void*)fwd_megakernel, dim3(grid_blocks), dim3(512), args, LDS_BYTES, stream);
    if (e != hipSuccess) fprintf(stderr, "cooperative launch failed: %s (grid %d)\n", hipGetErrorString(e), grid_blocks);
}
```
